# Optimizing an MI355X kernel written in HIP

```python
import jax, jax.numpy as jnp
from jax import lax
import numpy as np

D_MODEL = 1024
BATCH = 8
SEQ = 2048
DEPTH = 1

GRID_W = 64
CTX_LEN = 256
N_HEADS_NA = 8
HEAD_DIM = 64
D_NA = N_HEADS_NA * HEAD_DIM
NA_KH = 8
NA_KW = 16
D_SG = D_MODEL - D_NA
N_GROUPS_SG = 8
SG_GROUP_DIM = D_SG // N_GROUPS_SG
CHUNK = 128
D_MIX = D_NA + D_SG
D_IN = 3 * D_NA + 2 * D_SG
N_EXPERTS = 16
EC_CAPACITY_FACTOR = 2
D_EXPERT = 1536
N_MOD = 6
EPS = 1e-6
NEG_INF = -1e30

kernel_name = "hybrid_na_gmlp_ec_moe_dit"


def rmsnorm(x, g):
    xf = x.astype(jnp.float32)
    xf = xf * lax.rsqrt(jnp.mean(xf * xf, axis=-1, keepdims=True) + EPS)
    return xf.astype(x.dtype) * g


def layernorm(x, g):
    xf = x.astype(jnp.float32)
    mu = jnp.mean(xf, axis=-1, keepdims=True)
    var = jnp.mean(jnp.square(xf - mu), axis=-1, keepdims=True)
    return ((xf - mu) * lax.rsqrt(var + EPS)).astype(x.dtype) * g


def modulate(h, shift, scale):
    return h * (1 + scale) + shift


def split_in(z):
    q = z[..., :D_NA]
    k = z[..., D_NA:2 * D_NA]
    v = z[..., 2 * D_NA:3 * D_NA]
    u = z[..., 3 * D_NA:3 * D_NA + D_SG]
    zg = z[..., 3 * D_NA + D_SG:]
    return q, k, v, u, zg


def heads(t):
    return t.reshape(t.shape[:-1] + (N_HEADS_NA, HEAD_DIM))


def neighbourhood_attention(q, k, v, k_ctx, v_ctx, rpb):
    b, n, h, dh = q.shape
    rows = n // GRID_W
    kh = min(NA_KH, rows)
    r = np.arange(rows)
    row_start = np.clip(r - kh // 2, 0, rows - kh)
    row_idx = row_start[:, None] + np.arange(kh)[None, :]
    col = np.arange(GRID_W)
    col_start = np.clip(col - NA_KW // 2, 0, GRID_W - NA_KW)
    col_mask = (col[None, :] >= col_start[:, None]) & (col[None, :] < col_start[:, None] + NA_KW)
    row_off = row_idx - r[:, None] + NA_KH - 1
    col_off = np.clip(col[None, :] - col[:, None] + NA_KW - 1, 0, 2 * NA_KW - 2)
    bias = rpb[:, row_off[:, None, :, None], col_off[None, :, None, :]]

    qg = q.reshape(b, rows, GRID_W, h, dh)
    kg = k.reshape(b, rows, GRID_W, h, dh)[:, row_idx]
    vg = v.reshape(b, rows, GRID_W, h, dh)[:, row_idx]
    scale = dh ** -0.5
    s_nb = jnp.einsum('brqhd,brikhd->bhrqik', qg, kg).astype(jnp.float32) * scale + bias.astype(jnp.float32)[None]
    s_nb = jnp.where(col_mask[:, None, :], s_nb, NEG_INF)
    s_ctx = jnp.einsum('brqhd,bjhd->bhrqj', qg, k_ctx).astype(jnp.float32) * scale
    s = jnp.concatenate([s_nb.reshape(b, h, rows, GRID_W, kh * GRID_W), s_ctx], axis=-1)
    p = jax.nn.softmax(s, axis=-1).astype(v.dtype)
    p_nb = p[..., :kh * GRID_W].reshape(b, h, rows, GRID_W, kh, GRID_W)
    p_ctx = p[..., kh * GRID_W:]
    o = jnp.einsum('bhrqik,brikhd->brqhd', p_nb, vg) + jnp.einsum('bhrqj,bjhd->brqhd', p_ctx, v_ctx)
    return o.reshape(b, n, h * dh)


def context_attention(q, k, v):
    b, l, h, dh = q.shape
    s = jnp.einsum('bqhd,bkhd->bhqk', q, k).astype(jnp.float32) * dh ** -0.5
    p = jax.nn.softmax(s, axis=-1).astype(v.dtype)
    return jnp.einsum('bhqk,bkhd->bqhd', p, v).reshape(b, l, h * dh)


def chunk_gmlp(u, zg, w_s, b_s, g_norm):
    b, n, _ = u.shape
    u = jax.nn.gelu(u)
    zg = layernorm(jax.nn.gelu(zg), g_norm)
    zc = zg.reshape(b, n // CHUNK, CHUNK, N_GROUPS_SG, SG_GROUP_DIM)
    sp = jnp.einsum('gpq,bcqgd->bcpgd', w_s, zc) + b_s.T[None, None, :, :, None]
    return u * sp.reshape(b, n, D_SG)


def mix_out(o_a, o_b, out_norm_a, out_norm_b, w_out):
    o = jnp.concatenate([rmsnorm(o_a, out_norm_a), rmsnorm(o_b, out_norm_b)], axis=-1)
    return o @ w_out


def expert_choice_ffn(h, w_router, w_gate, w_up, w_down):
    b, n, d = h.shape
    cap = EC_CAPACITY_FACTOR * n // N_EXPERTS
    aff = jax.nn.softmax((h @ w_router).astype(jnp.float32), axis=-1)
    gates, idx = lax.top_k(jnp.swapaxes(aff, 1, 2), cap)
    xs = jax.vmap(lambda hb, ib: hb[ib])(h, idx)
    a = jnp.einsum('becd,edf->becf', xs, w_gate)
    up = jnp.einsum('becd,edf->becf', xs, w_up)
    y = jnp.einsum('becf,efd->becd', jax.nn.silu(a) * up, w_down) * gates[..., None].astype(h.dtype)
    return jax.vmap(lambda ib, yb: jnp.zeros((n, d), yb.dtype).at[ib.reshape(-1)].add(yb.reshape(-1, d)))(idx, y)


def setup_inputs(seed: int = 0) -> dict:
    key = jax.random.key(seed)
    ks = jax.random.split(key, 22)
    nrm = jax.random.normal
    f32 = jnp.float32
    return {
        "x": nrm(ks[0], (BATCH, SEQ, D_MODEL), f32),
        "c": nrm(ks[1], (BATCH, D_MODEL), f32),
        "ctx": nrm(ks[2], (BATCH, CTX_LEN, D_MODEL), f32),
        "c_ctx": nrm(ks[3], (D_MODEL,), f32),
        "w_mod": nrm(ks[4], (DEPTH, D_MODEL, N_MOD * D_MODEL), f32) * (0.5 * D_MODEL ** -0.5),
        "b_mod": nrm(ks[5], (DEPTH, N_MOD * D_MODEL), f32) * 0.01,
        "norm1": 1.0 + 0.02 * nrm(ks[6], (DEPTH, D_MODEL), f32),
        "w_in": nrm(ks[7], (DEPTH, D_MODEL, D_IN), f32) * D_MODEL ** -0.5,
        "rpb": 0.1 * nrm(ks[8], (DEPTH, N_HEADS_NA, 2 * NA_KH - 1, 2 * NA_KW - 1), f32),
        "w_s": nrm(ks[9], (DEPTH, N_GROUPS_SG, CHUNK, CHUNK), f32) * CHUNK ** -0.5,
        "b_s": 1.0 + 0.02 * nrm(ks[10], (DEPTH, N_GROUPS_SG, CHUNK), f32),
        "gmlp_norm": 1.0 + 0.02 * nrm(ks[11], (DEPTH, D_SG), f32),
        "out_norm_a": 1.0 + 0.02 * nrm(ks[12], (DEPTH, D_NA), f32),
        "out_norm_b": 1.0 + 0.02 * nrm(ks[13], (DEPTH, D_SG), f32),
        "w_out": nrm(ks[14], (DEPTH, D_MIX, D_MODEL), f32) * D_MIX ** -0.5,
        "norm2": 1.0 + 0.02 * nrm(ks[15], (DEPTH, D_MODEL), f32),
        "w_router": nrm(ks[16], (DEPTH, D_MODEL, N_EXPERTS), f32) * D_MODEL ** -0.5,
        "w_gate": nrm(ks[17], (DEPTH, N_EXPERTS, D_MODEL, D_EXPERT), f32) * D_MODEL ** -0.5,
        "w_up": nrm(ks[18], (DEPTH, N_EXPERTS, D_MODEL, D_EXPERT), f32) * D_MODEL ** -0.5,
        "w_down": nrm(ks[19], (DEPTH, N_EXPERTS, D_EXPERT, D_MODEL), f32) * D_EXPERT ** -0.5,
        "norm_final": 1.0 + 0.02 * nrm(ks[20], (D_MODEL,), f32),
    }


def reference(x, c, ctx, c_ctx, w_mod, b_mod, norm1, w_in, rpb, w_s, b_s, gmlp_norm,
              out_norm_a, out_norm_b, w_out, norm2, w_router, w_gate, w_up, w_down, norm_final):
    b = x.shape[0]
    for l in range(DEPTH):
        last = l == DEPTH - 1
        m = (jax.nn.silu(c) @ w_mod[l] + b_mod[l]).reshape(b, 1, N_MOD, D_MODEL)
        sh1, sc1, g1, sh2, sc2, g2 = (m[:, :, i] for i in range(N_MOD))
        mc = (jax.nn.silu(c_ctx) @ w_mod[l] + b_mod[l]).reshape(N_MOD, D_MODEL)
        sh1c, sc1c, g1c, sh2c, sc2c, g2c = (mc[i] for i in range(N_MOD))

        h = modulate(rmsnorm(x, norm1[l]), sh1, sc1)
        hc = modulate(rmsnorm(ctx, norm1[l]), sh1c, sc1c)
        q, k, v, u, zg = split_in(h @ w_in[l])
        if last:
            kv_c = hc @ w_in[l][:, D_NA:3 * D_NA]
            k_c, v_c = kv_c[..., :D_NA], kv_c[..., D_NA:]
        else:
            q_c, k_c, v_c, u_c, zg_c = split_in(hc @ w_in[l])
        o_a = neighbourhood_attention(heads(q), heads(k), heads(v), heads(k_c), heads(v_c), rpb[l])
        o_b = chunk_gmlp(u, zg, w_s[l], b_s[l], gmlp_norm[l])
        x_new = x + g1 * mix_out(o_a, o_b, out_norm_a[l], out_norm_b[l], w_out[l])

        if not last:
            o_ac = context_attention(heads(q_c), heads(k_c), heads(v_c))
            o_bc = chunk_gmlp(u_c, zg_c, w_s[l], b_s[l], gmlp_norm[l])
            ctx = ctx + g1c * mix_out(o_ac, o_bc, out_norm_a[l], out_norm_b[l], w_out[l])
            hc2 = modulate(rmsnorm(ctx, norm2[l]), sh2c, sc2c)
            ctx = ctx + g2c * expert_choice_ffn(hc2, w_router[l], w_gate[l], w_up[l], w_down[l])

        x = x_new
        h2 = modulate(rmsnorm(x, norm2[l]), sh2, sc2)
        x = x + g2 * expert_choice_ffn(h2, w_router[l], w_gate[l], w_up[l], w_down[l])
    return rmsnorm(x, norm_final)
```

```cpp
#include <hip/hip_runtime.h>
#include <cstdio>
#include <cstdint>

typedef unsigned short bf16_t;
typedef short bf16x8 __attribute__((ext_vector_type(8)));
typedef float f32x4 __attribute__((ext_vector_type(4)));
typedef float f32x2 __attribute__((ext_vector_type(2)));
typedef unsigned u32x4 __attribute__((ext_vector_type(4)));
typedef unsigned u32x2 __attribute__((ext_vector_type(2)));
typedef __bf16 bf16x2_t __attribute__((ext_vector_type(2)));

constexpr int NB = 8, SEQ = 2048, DM = 1024, NTOK = NB * SEQ, CTXL = 256, NCTX = NB * CTXL;
constexpr int GW = 64, ROWS = SEQ / GW;
constexpr int NH = 8, HD = 64, DNA = 512, DSG = 512, DIN = 2560;
constexpr int NE = 16, CAP = 256, DE = 1536, NMOD = 6 * DM;
constexpr float EPS = 1e-6f;
constexpr float LOG2E = 1.4426950408889634f;
constexpr float QSCALE = 0.125f * LOG2E;

constexpr size_t MiB = 1u << 20;
constexpr size_t WS_CTL = 0;
constexpr size_t WS_MOD = 1 * MiB;
constexpr size_t WS_STAT = 1 * MiB + 512 * 1024;
constexpr size_t WS_AFF = 2 * MiB;
constexpr size_t WS_GATE = 3 * MiB;
constexpr size_t WS_SEL = 4 * MiB;
constexpr size_t WS_WOUT = 5 * MiB;
constexpr size_t WS_WIN = 7 * MiB;
constexpr size_t WS_W2 = 12 * MiB;
constexpr size_t WS_W1 = 60 * MiB;
constexpr size_t WS_ACT = 156 * MiB;
constexpr size_t WS_Z = 156 * MiB;
constexpr size_t WS_ON = 156 * MiB;
constexpr size_t WS_H2 = 188 * MiB;
constexpr size_t WS_XS = 252 * MiB;
constexpr size_t WS_Y = 252 * MiB;
constexpr size_t WS_H = 252 * MiB;
constexpr size_t WS_KVC = 288 * MiB;
constexpr size_t WS_OPRE = 252 * MiB;
constexpr size_t WS_END = 316 * MiB;

struct Args { const float* in[21]; float* out; unsigned char* ws; int ph_lo, ph_hi; };

__device__ __forceinline__ unsigned cvtpk(float lo, float hi) { f32x2 v = {lo, hi}; bf16x2_t b = __builtin_convertvector(v, bf16x2_t); return __builtin_bit_cast(unsigned, b); }
__device__ __forceinline__ bf16_t f2bf(float f) { return (bf16_t)(cvtpk(f, 0.f) & 0xffffu); }
__device__ __forceinline__ float bf2f(bf16_t b) { return __uint_as_float(((unsigned)b) << 16); }
__device__ __forceinline__ float bflo(unsigned w) { return __uint_as_float(w << 16); }
__device__ __forceinline__ float bfhi(unsigned w) { return __uint_as_float(w & 0xffff0000u); }
__device__ __forceinline__ float wave_sum(float v) {
#pragma unroll
    for (int o = 1; o < 64; o <<= 1) v += __shfl_xor(v, o);
    return v;
}
__device__ __forceinline__ float wave_max(float v) {
#pragma unroll
    for (int o = 1; o < 64; o <<= 1) v = fmaxf(v, __shfl_xor(v, o));
    return v;
}
__device__ __forceinline__ float silu_f(float x) { return x / (1.f + __expf(-x)); }
__device__ __forceinline__ float gelu_tanh(float x) {
    const float u = 1.5957691216057308f * (x + 0.044715f * x * x * x);
    return x / (1.f + __expf(-u));
}

__device__ __forceinline__ void phase_mod(const Args& a, float* lds) {
    const float* c = a.in[1]; const float* cc = a.in[3]; const float* wm = a.in[4]; const float* bm = a.in[5];
    float* MOD = (float*)(a.ws + WS_MOD);
    float* s = lds;
    float* red = lds + 9 * 1024;
    const int t = threadIdx.x;
    for (int i = t; i < 9 * 1024; i += 512) { const float v = (i < 8192) ? c[i] : cc[i - 8192]; s[i] = silu_f(v); }
    __syncthreads();
    for (int item = blockIdx.x; item < NMOD / 32; item += gridDim.x) {
        const int col = item * 32 + (t & 31), kg = t >> 5;
        float acc[9];
#pragma unroll
        for (int r = 0; r < 9; ++r) acc[r] = 0.f;
        const float* wp = wm + (size_t)(kg * 64) * NMOD + col;
#pragma unroll 8
        for (int k = 0; k < 64; ++k) {
            const float w = wp[(size_t)k * NMOD];
#pragma unroll
            for (int r = 0; r < 9; ++r) acc[r] += s[r * 1024 + kg * 64 + k] * w;
        }
#pragma unroll
        for (int r = 0; r < 9; ++r) red[(kg * 9 + r) * 32 + (t & 31)] = acc[r];
        __syncthreads();
        if (t < 9 * 32) {
            const int r = t >> 5, cl = t & 31; float v = 0.f;
#pragma unroll
            for (int g = 0; g < 16; ++g) v += red[(g * 9 + r) * 32 + cl];
            MOD[r * NMOD + item * 32 + cl] = v + bm[item * 32 + cl];
        }
        __syncthreads();
    }
}

template <class RowMap>
__device__ __forceinline__ void transpose_item(const float* W, int K, int N, bf16_t* WT, RowMap rowmap, const float* kscale, int ksoff, float cs_lo, int cs_n, float* scr, int item, int lane) {
    const int nblk = N / 32, kb = item / nblk, nb = item % nblk, k0 = 64 * kb, n0 = 32 * nb;
#pragma unroll 8
    for (int i = 0; i < 32; ++i) { const int kk = 2 * i + (lane >> 5); float v = W[(size_t)(k0 + kk) * N + n0 + (lane & 31)]; if (kscale) v *= kscale[ksoff + k0 + kk]; scr[kk * 33 + (lane & 31)] = v; }
    __builtin_amdgcn_s_waitcnt(0xc07f); asm volatile("" ::: "memory");
    const int cch = lane & 7;
#pragma unroll
    for (int j = 0; j < 4; ++j) {
        const int n = (lane >> 3) + 8 * j; const float* sp = scr + (8 * cch) * 33 + n;
        const float sc = (n0 + n < cs_n) ? cs_lo : 1.f;
        u32x4 o; o.x = cvtpk(sp[0 * 33] * sc, sp[1 * 33] * sc); o.y = cvtpk(sp[2 * 33] * sc, sp[3 * 33] * sc); o.z = cvtpk(sp[4 * 33] * sc, sp[5 * 33] * sc); o.w = cvtpk(sp[6 * 33] * sc, sp[7 * 33] * sc);
        *(u32x4*)(WT + (size_t)rowmap(n0 + n) * K + k0 + 8 * cch) = o;
    }
    __builtin_amdgcn_s_waitcnt(0xc07f); asm volatile("" ::: "memory");
}
struct RowId { int off; __device__ int operator()(int n) const { return off + n; } };
struct RowGU { int off; __device__ int operator()(int n) const { return off + (n >> 7) * 256 + (n & 127); } };

__device__ __forceinline__ void phase_wconv(const Args& a, float* lds) {
    const int wave = threadIdx.x >> 6, lane = threadIdx.x & 63;
    float* scr = lds + wave * (64 * 33);
    const int gw = blockIdx.x * 8 + wave, NGW = gridDim.x * 8;
    bf16_t* WIN = (bf16_t*)(a.ws + WS_WIN); bf16_t* WOUT = (bf16_t*)(a.ws + WS_WOUT); bf16_t* W1 = (bf16_t*)(a.ws + WS_W1); bf16_t* W2 = (bf16_t*)(a.ws + WS_W2);
    constexpr int I_IN = (DM / 64) * (DIN / 32), I_OUT = (DM / 64) * (DM / 32), I_G = (DM / 64) * (DE / 32), I_D = (DE / 64) * (DM / 32);
    constexpr int NITEMS = I_IN + I_OUT + NE * (2 * I_G + I_D);
    for (int it = gw; it < NITEMS; it += NGW) {
        int r = it;
        if (r < I_IN) { transpose_item(a.in[7], DM, DIN, WIN, RowId{0}, nullptr, 0, QSCALE, DNA, scr, r, lane); continue; } r -= I_IN;
        if (r < I_OUT) {
            const int kb = r / (DM / 32); const float* g = (kb * 64 < DNA) ? a.in[12] : a.in[13];
            transpose_item(a.in[14], DM, DM, WOUT, RowId{0}, g, (kb * 64 < DNA) ? 0 : -DNA, 1.f, 0, scr, r, lane); continue; } r -= I_OUT;
        const int e = r / (2 * I_G + I_D); r -= e * (2 * I_G + I_D);
        if (r < I_G) { transpose_item(a.in[17] + (size_t)e * DM * DE, DM, DE, W1 + (size_t)e * 3072 * DM, RowGU{0}, nullptr, 0, 1.f, 0, scr, r, lane); continue; } r -= I_G;
        if (r < I_G) { transpose_item(a.in[18] + (size_t)e * DM * DE, DM, DE, W1 + (size_t)e * 3072 * DM, RowGU{128}, nullptr, 0, 1.f, 0, scr, r, lane); continue; } r -= I_G;
        transpose_item(a.in[19] + (size_t)e * DE * DM, DE, DM, W2 + (size_t)e * DM * DE, RowId{0}, nullptr, 0, 1.f, 0, scr, r, lane);
    }
}

__device__ __forceinline__ void phase_prenorm(const Args& a) {
    const int wave = threadIdx.x >> 6, lane = threadIdx.x & 63;
    const int gw = blockIdx.x * 8 + wave, NGW = gridDim.x * 8;
    const float* MOD = (const float*)(a.ws + WS_MOD); bf16_t* H = (bf16_t*)(a.ws + WS_H);
    const f32x4* n1 = (const f32x4*)a.in[6] + lane;
    for (int m = gw; m < NTOK + NCTX; m += NGW) {
        const float* xrow = (m < NTOK) ? a.in[0] + (size_t)m * DM : a.in[2] + (size_t)(m - NTOK) * DM;
        const int mr = (m < NTOK) ? m / SEQ : 8;
        const f32x4* xr = (const f32x4*)xrow + lane;
        const f32x4* sh = (const f32x4*)(MOD + mr * NMOD) + lane; const f32x4* sc = (const f32x4*)(MOD + mr * NMOD + DM) + lane;
        f32x4 v[4]; float s = 0.f;
#pragma unroll
        for (int j = 0; j < 4; ++j) { v[j] = xr[64 * j]; s += (v[j].x * v[j].x + v[j].y * v[j].y) + (v[j].z * v[j].z + v[j].w * v[j].w); }
        const float rstd = rsqrtf(wave_sum(s) * (1.f / DM) + EPS);
        u32x2* o = (u32x2*)(H + (size_t)m * DM) + lane;
#pragma unroll
        for (int j = 0; j < 4; ++j) {
            const f32x4 g = n1[64 * j], s1 = sc[64 * j], h1 = sh[64 * j];
            const f32x4 y = (v[j] * rstd) * g * (s1 + 1.f) + h1;
            u32x2 w; w.x = cvtpk(y.x, y.y); w.y = cvtpk(y.z, y.w); o[64 * j] = w;
        }
    }
}

template <class BRow>
__device__ __forceinline__ void wave_gemm(const bf16_t* A, int lda, int row0, const bf16_t* Bt, int ldb, int K, BRow brow, f32x4 (&acc)[4][4], int lane) {
    const int fr = lane & 15, fq = lane >> 4;
    const bf16_t* ap0 = A + (size_t)(row0 + fr) * lda + fq * 8;
    const bf16_t* bp0 = Bt + (size_t)(brow(0) + fr) * ldb + fq * 8;
    const bf16_t* bp1 = Bt + (size_t)(brow(1) + fr) * ldb + fq * 8;
    const bf16_t* bp2 = Bt + (size_t)(brow(2) + fr) * ldb + fq * 8;
    const bf16_t* bp3 = Bt + (size_t)(brow(3) + fr) * ldb + fq * 8;
#pragma unroll
    for (int mi = 0; mi < 4; ++mi)
#pragma unroll
        for (int ni = 0; ni < 4; ++ni) acc[mi][ni] = (f32x4){0.f, 0.f, 0.f, 0.f};
    for (int k0 = 0; k0 < K; k0 += 32) {
        bf16x8 af[4], bfr[4];
#pragma unroll
        for (int mi = 0; mi < 4; ++mi) af[mi] = *(const bf16x8*)(ap0 + (size_t)mi * 16 * lda + k0);
        bfr[0] = *(const bf16x8*)(bp0 + k0); bfr[1] = *(const bf16x8*)(bp1 + k0); bfr[2] = *(const bf16x8*)(bp2 + k0); bfr[3] = *(const bf16x8*)(bp3 + k0);
#pragma unroll
        for (int mi = 0; mi < 4; ++mi)
#pragma unroll
            for (int ni = 0; ni < 4; ++ni) acc[mi][ni] = __builtin_amdgcn_mfma_f32_16x16x32_bf16(af[mi], bfr[ni], acc[mi][ni], 0, 0, 0);
    }
}
struct BRowStd { int n0; __device__ int operator()(int ni) const { return n0 + ni * 16; } };
struct BRowGU { int base; __device__ int operator()(int ni) const { return base + (ni >> 1) * 128 + (ni & 1) * 16; } };

__global__ void __launch_bounds__(256) k_inproj_naive(Args a) {
    const int wave = threadIdx.x >> 6, lane = threadIdx.x & 63, fr = lane & 15, fq = lane >> 4;
    const int row0 = blockIdx.y * 128 + (wave >> 1) * 64, col0 = blockIdx.x * 128 + (wave & 1) * 64;
    const bool isctx = row0 >= NTOK;
    if (isctx && (col0 < 512 || col0 >= 1536)) return;
    const bf16_t* H = (const bf16_t*)(a.ws + WS_H); const bf16_t* WIN = (const bf16_t*)(a.ws + WS_WIN);
    bf16_t* Z = (bf16_t*)(a.ws + WS_Z); bf16_t* KVC = (bf16_t*)(a.ws + WS_KVC);
    f32x4 acc[4][4];
    wave_gemm(H, DM, row0, WIN, DM, DM, BRowStd{col0}, acc, lane);
#pragma unroll
    for (int mi = 0; mi < 4; ++mi)
#pragma unroll
        for (int ni = 0; ni < 4; ++ni)
#pragma unroll
            for (int j = 0; j < 4; ++j) {
                const int row = row0 + mi * 16 + fq * 4 + j, col = col0 + ni * 16 + fr; float v = acc[mi][ni][j];
                if (isctx) KVC[(size_t)(row - NTOK) * DM + (col - 512)] = f2bf(v);
                else { if (col >= 1536) v = gelu_tanh(v); Z[(size_t)row * DIN + col] = f2bf(v); }
            }
}

__global__ void __launch_bounds__(256) k_outproj_naive(Args a) {
    const int wave = threadIdx.x >> 6, lane = threadIdx.x & 63, fr = lane & 15, fq = lane >> 4;
    const int row0 = blockIdx.y * 128 + (wave >> 1) * 64, col0 = blockIdx.x * 128 + (wave & 1) * 64;
    const bf16_t* ON = (const bf16_t*)(a.ws + WS_ON); const bf16_t* WOUT = (const bf16_t*)(a.ws + WS_WOUT);
    const float* MOD = (const float*)(a.ws + WS_MOD); const float* x = a.in[0];
    f32x4 acc[4][4];
    wave_gemm(ON, DM, row0, WOUT, DM, DM, BRowStd{col0}, acc, lane);
    const int b = row0 / SEQ;
#pragma unroll
    for (int mi = 0; mi < 4; ++mi)
#pragma unroll
        for (int ni = 0; ni < 4; ++ni)
#pragma unroll
            for (int j = 0; j < 4; ++j) {
                const int row = row0 + mi * 16 + fq * 4 + j, col = col0 + ni * 16 + fr;
                a.out[(size_t)row * DM + col] = x[(size_t)row * DM + col] + MOD[b * NMOD + 2 * DM + col] * acc[mi][ni][j];
            }
}

__global__ void __launch_bounds__(256) k_moe1_naive(Args a) {
    const int wave = threadIdx.x >> 6, lane = threadIdx.x & 63, fr = lane & 15, fq = lane >> 4, e = blockIdx.z;
    const int row0 = e * 2048 + blockIdx.y * 128 + (wave >> 1) * 64, f0 = blockIdx.x * 64 + (wave & 1) * 32;
    const bf16_t* XS = (const bf16_t*)(a.ws + WS_XS); const bf16_t* W1 = (const bf16_t*)(a.ws + WS_W1) + (size_t)e * 3072 * DM;
    bf16_t* ACT = (bf16_t*)(a.ws + WS_ACT);
    f32x4 acc[4][4];
    wave_gemm(XS, DM, row0, W1, DM, DM, BRowGU{(f0 >> 7) * 256 + (f0 & 127)}, acc, lane);
#pragma unroll
    for (int mi = 0; mi < 4; ++mi)
#pragma unroll
        for (int ni = 0; ni < 2; ++ni)
#pragma unroll
            for (int j = 0; j < 4; ++j) {
                const int row = row0 + mi * 16 + fq * 4 + j, f = f0 + ni * 16 + fr;
                const float g = acc[mi][ni][j], u = acc[mi][ni + 2][j];
                ACT[(size_t)row * DE + f] = f2bf(silu_f(g) * u);
            }
}

__global__ void __launch_bounds__(256) k_moe2_naive(Args a) {
    const int wave = threadIdx.x >> 6, lane = threadIdx.x & 63, fr = lane & 15, fq = lane >> 4, e = blockIdx.z;
    const int row0 = e * 2048 + blockIdx.y * 128 + (wave >> 1) * 64, col0 = blockIdx.x * 128 + (wave & 1) * 64;
    const bf16_t* ACT = (const bf16_t*)(a.ws + WS_ACT); const bf16_t* W2 = (const bf16_t*)(a.ws + WS_W2) + (size_t)e * DM * DE;
    const float* GATE = (const float*)(a.ws + WS_GATE); bf16_t* Y = (bf16_t*)(a.ws + WS_Y);
    f32x4 acc[4][4];
    wave_gemm(ACT, DE, row0, W2, DE, DE, BRowStd{col0}, acc, lane);
#pragma unroll
    for (int mi = 0; mi < 4; ++mi)
#pragma unroll
        for (int ni = 0; ni < 4; ++ni)
#pragma unroll
            for (int j = 0; j < 4; ++j) {
                const int row = row0 + mi * 16 + fq * 4 + j, col = col0 + ni * 16 + fr;
                const int bb = (row >> 8) & 7, s = row & 255;
                Y[(size_t)row * DM + col] = f2bf(acc[mi][ni][j] * GATE[(bb * NE + e) * CAP + s]);
            }
}

__global__ void __launch_bounds__(256) k_attn_naive(Args a) {
    const int wave = threadIdx.x >> 6, lane = threadIdx.x & 63;
    const int gq = blockIdx.x * 4 + wave;
    const int t = gq & (SEQ - 1), h = (gq >> 11) & 7, b = gq >> 14;
    const int r = t >> 6, c = t & 63;
    const int rs = min(max(r - 4, 0), ROWS - 8), cs = min(max(c - 8, 0), GW - 16);
    const bf16_t* Z = (const bf16_t*)(a.ws + WS_Z); const bf16_t* KVC = (const bf16_t*)(a.ws + WS_KVC);
    bf16_t* OP = (bf16_t*)(a.ws + WS_OPRE); const float* rpb = a.in[8];
    __shared__ float pl[4][384];
    float q[64];
    const bf16_t* qp = Z + (size_t)(b * SEQ + t) * DIN + h * HD;
#pragma unroll
    for (int d = 0; d < 64; ++d) q[d] = bf2f(qp[d]);
    float sv[6]; float mx = -1e30f;
#pragma unroll
    for (int i = 0; i < 6; ++i) {
        const bf16_t* kp; float bias = 0.f;
        if (i < 2) { const int w = lane + 64 * i, wr = w >> 4, wc = w & 15; const int kr = rs + wr, kc = cs + wc;
            kp = Z + (size_t)(b * SEQ + kr * GW + kc) * DIN + DNA + h * HD;
            bias = LOG2E * rpb[(h * 15 + (kr - r + 7)) * 31 + (kc - c + 15)]; }
        else { const int j = lane + 64 * (i - 2); kp = KVC + (size_t)(b * CTXL + j) * DM + h * HD; }
        float s = 0.f;
#pragma unroll
        for (int d = 0; d < 64; ++d) s += q[d] * bf2f(kp[d]);
        sv[i] = s + bias; mx = fmaxf(mx, sv[i]);
    }
    mx = wave_max(mx);
    float l = 0.f;
#pragma unroll
    for (int i = 0; i < 6; ++i) { const float p = exp2f(sv[i] - mx); l += p; pl[wave][lane + 64 * i] = p; }
    l = wave_sum(l);
    __syncthreads();
    float o = 0.f;
    for (int i = 0; i < 384; ++i) {
        const bf16_t* vp;
        if (i < 128) { const int wr = i >> 4, wc = i & 15; vp = Z + (size_t)(b * SEQ + (rs + wr) * GW + cs + wc) * DIN + 2 * DNA + h * HD; }
        else vp = KVC + (size_t)(b * CTXL + (i - 128)) * DM + DNA + h * HD;
        o += pl[wave][i] * bf2f(vp[lane]);
    }
    OP[(size_t)(b * SEQ + t) * DM + h * HD + lane] = f2bf(o / l);
}

__global__ void __launch_bounds__(256) k_gmlp_stats(Args a) {
    const int wave = threadIdx.x >> 6, lane = threadIdx.x & 63; const int row = blockIdx.x * 4 + wave;
    const bf16_t* Z = (const bf16_t*)(a.ws + WS_Z); float* ST = (float*)(a.ws + WS_STAT);
    const u32x4 w = *((const u32x4*)(Z + (size_t)row * DIN + 2048) + lane);
    float v[8] = {bflo(w.x), bfhi(w.x), bflo(w.y), bfhi(w.y), bflo(w.z), bfhi(w.z), bflo(w.w), bfhi(w.w)};
    float s = 0.f;
#pragma unroll
    for (int i = 0; i < 8; ++i) s += v[i];
    const float mean = wave_sum(s) * (1.f / DSG); float q = 0.f;
#pragma unroll
    for (int i = 0; i < 8; ++i) { const float d = v[i] - mean; q += d * d; }
    const float rstd = rsqrtf(wave_sum(q) * (1.f / DSG) + EPS);
    if (lane == 0) { ST[row * 2] = mean; ST[row * 2 + 1] = rstd; }
}
__global__ void __launch_bounds__(512) k_gmlp_naive(Args a) {
    const int row = blockIdx.x, ch = threadIdx.x, g = ch >> 6, p = row & 127, base = row - p;
    const bf16_t* Z = (const bf16_t*)(a.ws + WS_Z); const float* ST = (const float*)(a.ws + WS_STAT);
    const float* ws_ = a.in[9] + (size_t)(g * 128 + p) * 128; const float gn = a.in[11][ch];
    float acc = 0.f;
    for (int qi = 0; qi < 128; ++qi) {
        const float z = bf2f(Z[(size_t)(base + qi) * DIN + 2048 + ch]);
        const float zn = (z - ST[(base + qi) * 2]) * ST[(base + qi) * 2 + 1] * gn;
        acc += ws_[qi] * zn;
    }
    acc += a.in[10][g * 128 + p];
    const float u = bf2f(Z[(size_t)row * DIN + 1536 + ch]);
    ((bf16_t*)(a.ws + WS_OPRE))[(size_t)row * DM + DNA + ch] = f2bf(u * acc);
}

__device__ __forceinline__ void phase_onorm(const Args& a) {
    const int wave = threadIdx.x >> 6, lane = threadIdx.x & 63;
    const int gw = blockIdx.x * 8 + wave, NGW = gridDim.x * 8;
    const bf16_t* OP = (const bf16_t*)(a.ws + WS_OPRE); bf16_t* ON = (bf16_t*)(a.ws + WS_ON);
    for (int m = gw; m < NTOK; m += NGW) {
#pragma unroll
        for (int hf = 0; hf < 2; ++hf) {
            const u32x4 w = *((const u32x4*)(OP + (size_t)m * DM + hf * 512) + lane);
            float v[8] = {bflo(w.x), bfhi(w.x), bflo(w.y), bfhi(w.y), bflo(w.z), bfhi(w.z), bflo(w.w), bfhi(w.w)};
            float s = 0.f;
#pragma unroll
            for (int i = 0; i < 8; ++i) s += v[i] * v[i];
            const float rstd = rsqrtf(wave_sum(s) * (1.f / 512.f) + EPS);
            u32x4 o; o.x = cvtpk(v[0] * rstd, v[1] * rstd); o.y = cvtpk(v[2] * rstd, v[3] * rstd); o.z = cvtpk(v[4] * rstd, v[5] * rstd); o.w = cvtpk(v[6] * rstd, v[7] * rstd);
            *((u32x4*)(ON + (size_t)m * DM + hf * 512) + lane) = o;
        }
    }
}

__device__ __forceinline__ void phase_norm2(const Args& a) {
    const int wave = threadIdx.x >> 6, lane = threadIdx.x & 63;
    const int gw = blockIdx.x * 8 + wave, NGW = gridDim.x * 8;
    const float* MOD = (const float*)(a.ws + WS_MOD); bf16_t* H2 = (bf16_t*)(a.ws + WS_H2); float* AFF = (float*)(a.ws + WS_AFF);
    const f32x4* n2 = (const f32x4*)a.in[15] + lane; const float* wr = a.in[16];
    for (int m = gw; m < NTOK; m += NGW) {
        const int b = m / SEQ, n = m % SEQ;
        const f32x4* xr = (const f32x4*)(a.out + (size_t)m * DM) + lane;
        const f32x4* sh = (const f32x4*)(MOD + b * NMOD + 3 * DM) + lane; const f32x4* sc = (const f32x4*)(MOD + b * NMOD + 4 * DM) + lane;
        f32x4 v[4]; float s = 0.f;
#pragma unroll
        for (int j = 0; j < 4; ++j) { v[j] = xr[64 * j]; s += (v[j].x * v[j].x + v[j].y * v[j].y) + (v[j].z * v[j].z + v[j].w * v[j].w); }
        const float rstd = rsqrtf(wave_sum(s) * (1.f / DM) + EPS);
        float lg[16];
#pragma unroll
        for (int e = 0; e < 16; ++e) lg[e] = 0.f;
        u32x2* o = (u32x2*)(H2 + (size_t)m * DM) + lane;
#pragma unroll
        for (int j = 0; j < 4; ++j) {
            const f32x4 g = n2[64 * j], s1 = sc[64 * j], h1 = sh[64 * j];
            const f32x4 y = (v[j] * rstd) * g * (s1 + 1.f) + h1;
            u32x2 w; w.x = cvtpk(y.x, y.y); w.y = cvtpk(y.z, y.w); o[64 * j] = w;
            const int k0 = (64 * j + lane) * 4;
#pragma unroll
            for (int i = 0; i < 4; ++i) {
                const f32x4* wp = (const f32x4*)(wr + (size_t)(k0 + i) * NE);
                const float yv = y[i];
#pragma unroll
                for (int e4 = 0; e4 < 4; ++e4) { const f32x4 w4 = wp[e4]; lg[e4 * 4 + 0] += yv * w4.x; lg[e4 * 4 + 1] += yv * w4.y; lg[e4 * 4 + 2] += yv * w4.z; lg[e4 * 4 + 3] += yv * w4.w; }
            }
        }
        float mx = -1e30f;
#pragma unroll
        for (int e = 0; e < 16; ++e) { lg[e] = wave_sum(lg[e]); mx = fmaxf(mx, lg[e]); }
        float den = 0.f;
#pragma unroll
        for (int e = 0; e < 16; ++e) { lg[e] = __expf(lg[e] - mx); den += lg[e]; }
        const float inv = 1.f / den;
        float mine = 0.f;
#pragma unroll
        for (int e = 0; e < 16; ++e) mine = (lane == e) ? lg[e] * inv : mine;
        if (lane < 16) AFF[((size_t)b * NE + lane) * SEQ + n] = mine;
    }
}

__device__ __forceinline__ void phase_topk(const Args& a, float* lds) {
    const int t = threadIdx.x, wave = t >> 6, lane = t & 63;
    const float* AFF = (const float*)(a.ws + WS_AFF); float* GATE = (float*)(a.ws + WS_GATE); int* SEL = (int*)(a.ws + WS_SEL);
    const bf16_t* H2 = (const bf16_t*)(a.ws + WS_H2); bf16_t* XS = (bf16_t*)(a.ws + WS_XS);
    float* v = lds;
    int* list = (int*)(lds + 2048);
    int* cnt = (int*)(lds + 2048 + 512);
    for (int item = blockIdx.x; item < NB * NE * 4; item += gridDim.x) {
        const int qd = item & 3, e = (item >> 2) & 15, b = item >> 6;
        const float* src = AFF + ((size_t)b * NE + e) * SEQ;
        for (int i = t; i < SEQ; i += 512) v[i] = src[i];
        if (t == 0) *cnt = 0;
        __syncthreads();
        const int n = qd * 512 + t; const float mv = v[n]; int rank = 0;
        const f32x4* v4 = (const f32x4*)v;
        for (int i = 0; i < SEQ / 4; ++i) {
            const f32x4 x = v4[i]; const int m0 = 4 * i;
            rank += (x.x > mv || (x.x == mv && m0 + 0 < n)) ? 1 : 0;
            rank += (x.y > mv || (x.y == mv && m0 + 1 < n)) ? 1 : 0;
            rank += (x.z > mv || (x.z == mv && m0 + 2 < n)) ? 1 : 0;
            rank += (x.w > mv || (x.w == mv && m0 + 3 < n)) ? 1 : 0;
        }
        int sel = -1;
        if (rank < CAP) { sel = rank; GATE[(b * NE + e) * CAP + rank] = mv; const int pos = atomicAdd(cnt, 1); list[pos] = n | (rank << 16); }
        SEL[((size_t)b * SEQ + n) * NE + e] = sel;
        __syncthreads();
        const int nsel = *cnt;
        for (int i = wave; i < nsel; i += 8) {
            const int tok = list[i] & 0xffff, rk = list[i] >> 16;
            const u32x4* s4 = (const u32x4*)(H2 + (size_t)(b * SEQ + tok) * DM) + lane;
            u32x4* d4 = (u32x4*)(XS + (size_t)((e * NB + b) * CAP + rk) * DM) + lane;
            d4[0] = s4[0]; d4[64] = s4[64];
        }
        __syncthreads();
    }
}

__device__ __forceinline__ void phase_final(const Args& a) {
    const int wave = threadIdx.x >> 6, lane = threadIdx.x & 63;
    const int gw = blockIdx.x * 8 + wave, NGW = gridDim.x * 8;
    const float* MOD = (const float*)(a.ws + WS_MOD); const int* SEL = (const int*)(a.ws + WS_SEL); const bf16_t* Y = (const bf16_t*)(a.ws + WS_Y);
    const f32x4* nf = (const f32x4*)a.in[20] + lane;
    for (int m = gw; m < NTOK; m += NGW) {
        const int b = m / SEQ;
        f32x4* xr = (f32x4*)(a.out + (size_t)m * DM) + lane;
        const f32x4* g2 = (const f32x4*)(MOD + b * NMOD + 5 * DM) + lane;
        f32x4 acc[4];
#pragma unroll
        for (int j = 0; j < 4; ++j) acc[j] = (f32x4){0.f, 0.f, 0.f, 0.f};
        const int mysel = (lane < NE) ? SEL[(size_t)m * NE + lane] : -1;
        for (int e = 0; e < NE; ++e) {
            const int sl = __shfl(mysel, e);
            if (sl >= 0) {
                const u32x2* yr = (const u32x2*)(Y + (size_t)((e * NB + b) * CAP + sl) * DM) + lane;
#pragma unroll
                for (int j = 0; j < 4; ++j) { const u32x2 w = yr[64 * j]; acc[j].x += bflo(w.x); acc[j].y += bfhi(w.x); acc[j].z += bflo(w.y); acc[j].w += bfhi(w.y); }
            }
        }
        f32x4 v[4]; float s = 0.f;
#pragma unroll
        for (int j = 0; j < 4; ++j) { v[j] = xr[64 * j] + g2[64 * j] * acc[j]; s += (v[j].x * v[j].x + v[j].y * v[j].y) + (v[j].z * v[j].z + v[j].w * v[j].w); }
        const float rstd = rsqrtf(wave_sum(s) * (1.f / DM) + EPS);
#pragma unroll
        for (int j = 0; j < 4; ++j) xr[64 * j] = (v[j] * rstd) * nf[64 * j];
    }
}

__global__ void __launch_bounds__(512) k_simple(Args a, int which) {
    extern __shared__ __attribute__((aligned(16))) unsigned char lds_raw[];
    float* lds = (float*)lds_raw;
    if (which == 0) { phase_mod(a, lds); }
    else if (which == 1) { phase_wconv(a, lds); }
    else if (which == 2) { phase_prenorm(a); }
    else if (which == 3) { phase_onorm(a); }
    else if (which == 4) { phase_norm2(a); }
    else if (which == 5) { phase_topk(a, lds); }
    else if (which == 6) { phase_final(a); }
}

extern "C" void kernel_launch(void* const* d_in, const int* in_sizes, int n_in, void* d_out, int out_size, void* d_ws, size_t ws_size, hipStream_t stream) {
    static int ok = 0;
    if (ok == 0) {
        if (n_in != 21 || out_size != NTOK * DM || ws_size < WS_END) { fprintf(stderr, "kernel_launch: unexpected shapes n_in %d out %d ws %zu\n", n_in, out_size, ws_size); ok = -1; return; }
        (void)hipFuncSetAttribute((const void*)k_simple, hipFuncAttributeMaxDynamicSharedMemorySize, 72 * 1024);
        ok = 1;
    }
    if (ok < 0) return;
    Args a{};
    for (int i = 0; i < 21; ++i) a.in[i] = (const float*)d_in[i];
    a.out = (float*)d_out; a.ws = (unsigned char*)d_ws; a.ph_lo = 0; a.ph_hi = 0;
    const int LDSB = 72 * 1024;
    hipLaunchKernelGGL(k_simple, dim3(256), dim3(512), LDSB, stream, a, 0);
    hipLaunchKernelGGL(k_simple, dim3(256), dim3(512), LDSB, stream, a, 1);
    hipLaunchKernelGGL(k_simple, dim3(256), dim3(512), LDSB, stream, a, 2);
    hipLaunchKernelGGL(k_inproj_naive, dim3(DIN / 128, (NTOK + NCTX) / 128), dim3(256), 0, stream, a);
    hipLaunchKernelGGL(k_attn_naive, dim3(NB * NH * SEQ / 4), dim3(256), 0, stream, a);
    hipLaunchKernelGGL(k_gmlp_stats, dim3(NTOK / 4), dim3(256), 0, stream, a);
    hipLaunchKernelGGL(k_gmlp_naive, dim3(NTOK), dim3(512), 0, stream, a);
    hipLaunchKernelGGL(k_simple, dim3(256), dim3(512), LDSB, stream, a, 3);
    hipLaunchKernelGGL(k_outproj_naive, dim3(DM / 128, NTOK / 128), dim3(256), 0, stream, a);
    hipLaunchKernelGGL(k_simple, dim3(256), dim3(512), LDSB, stream, a, 4);
    hipLaunchKernelGGL(k_simple, dim3(256), dim3(512), LDSB, stream, a, 5);
    hipLaunchKernelGGL(k_moe1_naive, dim3(DE / 64, 2048 / 128, NE), dim3(256), 0, stream, a);
    hipLaunchKernelGGL(k_moe2_naive, dim3(DM / 128, 2048 / 128, NE), dim3(256), 0, stream, a);
    hipLaunchKernelGGL(k_simple, dim3(256), dim3(512), LDSB, stream, a, 6);
}
```

```cpp
#include <hip/hip_runtime.h>
#include <cstdio>
#include <cstdint>
#ifndef REP_MASK_V
#define REP_MASK_V 0u
#endif

typedef unsigned short bf16_t;
typedef short bf16x8 __attribute__((ext_vector_type(8)));
typedef float f32x4 __attribute__((ext_vector_type(4)));
typedef float f32x2 __attribute__((ext_vector_type(2)));
typedef unsigned u32x4 __attribute__((ext_vector_type(4)));
typedef unsigned u32x2 __attribute__((ext_vector_type(2)));
typedef __bf16 bf16x2_t __attribute__((ext_vector_type(2)));

constexpr int NB = 8, SEQ = 2048, DM = 1024, NTOK = NB * SEQ, CTXL = 256, NCTX = NB * CTXL;
constexpr int GW = 64, ROWS = SEQ / GW;
constexpr int NH = 8, HD = 64, DNA = 512, DSG = 512, DIN = 2560;
constexpr int NE = 16, CAP = 256, DE = 1536, NMOD = 6 * DM;
constexpr float EPS = 1e-6f;
constexpr float LOG2E = 1.4426950408889634f;
constexpr float Y8_SCALE = 64.f;
constexpr float W8_SCALE = 128.f, A8_SCALE = 4.f;
constexpr float QSCALE = 0.125f * LOG2E;

constexpr size_t MiB = 1u << 20;
constexpr size_t WS_CTL = 0;
constexpr size_t WS_PCNT = 128 * 1024;
constexpr size_t WS_SS = 256 * 1024;
constexpr size_t WS_MOD = 1 * MiB;
constexpr size_t WS_AFF = 2 * MiB;
constexpr size_t WS_GATE = 3 * MiB;
constexpr size_t WS_IDX = 3 * MiB + 512 * 1024;
constexpr size_t WS_SEL = 4 * MiB;
constexpr size_t WS_WOUT = 5 * MiB;
constexpr size_t WS_WIN = 7 * MiB;
constexpr size_t WS_W2 = 12 * MiB;
constexpr size_t WS_W1 = 60 * MiB;
constexpr size_t WS_XNB = 108 * MiB;
constexpr size_t WS_ACT = 156 * MiB;
constexpr size_t WS_Z = 156 * MiB;
constexpr size_t WS_H2 = 252 * MiB;
constexpr size_t WS_Y = 252 * MiB;
constexpr size_t WS_H = 252 * MiB;
constexpr size_t WS_KVC = 288 * MiB;
constexpr size_t WS_OPRE = 252 * MiB;
constexpr size_t WS_END = 316 * MiB;

struct Args { const float* in[21]; float* out; unsigned char* ws; int ph_lo, ph_hi; };

__device__ __forceinline__ unsigned cvtpk(float lo, float hi) { f32x2 v = {lo, hi}; bf16x2_t b = __builtin_convertvector(v, bf16x2_t); return __builtin_bit_cast(unsigned, b); }
__device__ __forceinline__ bf16_t f2bf(float f) { return (bf16_t)(cvtpk(f, 0.f) & 0xffffu); }
__device__ __forceinline__ float bf2f(bf16_t b) { return __uint_as_float(((unsigned)b) << 16); }
__device__ __forceinline__ float bflo(unsigned w) { return __uint_as_float(w << 16); }
__device__ __forceinline__ float bfhi(unsigned w) { return __uint_as_float(w & 0xffff0000u); }
__device__ __forceinline__ float clamp8(float v) { return __builtin_fminf(__builtin_fmaxf(v, -448.f), 448.f); }
__device__ __forceinline__ unsigned cvt4_fp8(float a, float b, float c, float d) {
    int w = __builtin_amdgcn_cvt_pk_fp8_f32(clamp8(a), clamp8(b), 0, false); w = __builtin_amdgcn_cvt_pk_fp8_f32(clamp8(c), clamp8(d), w, true); return (unsigned)w;
}
#define LDS_BARRIER() asm volatile("s_waitcnt lgkmcnt(0)\n\ts_barrier" ::: "memory")
__device__ __forceinline__ float wave_sum(float v) {
#pragma unroll
    for (int o = 1; o < 64; o <<= 1) v += __shfl_xor(v, o);
    return v;
}
__device__ __forceinline__ float wave_max(float v) {
#pragma unroll
    for (int o = 1; o < 64; o <<= 1) v = fmaxf(v, __shfl_xor(v, o));
    return v;
}
__device__ __forceinline__ float silu_f(float x) { return x / (1.f + __expf(-x)); }
__device__ __forceinline__ float gelu_tanh(float x) {
    const float u = 1.5957691216057308f * (x + 0.044715f * x * x * x);
    return x / (1.f + __expf(-u));
}

constexpr int MOD_PRE_ITEMS = 2 * DM / 32;
__device__ __forceinline__ void phase_mod(const Args& a, float* lds) {
    const float* c = a.in[1]; const float* cc = a.in[3]; const float* wm = a.in[4]; const float* bm = a.in[5];
    float* MOD = (float*)(a.ws + WS_MOD);
    float* s = lds;
    float* red = lds + 1024 * 12;
    const int t = threadIdx.x;
    const int item0 = blockIdx.x; const bool has = item0 < NMOD / 32;
    const int col = item0 * 32 + (t & 31), kg = t >> 5;
    float w[64];
    if (has) { const float* wp = wm + (size_t)(kg * 64) * NMOD + col;
#pragma unroll
        for (int k = 0; k < 64; ++k) w[k] = __builtin_nontemporal_load(wp + (size_t)k * NMOD); }
    for (int i = t; i < 9 * 1024; i += 512) { const int r = i >> 10, k = i & 1023; const float v = (r < 8) ? c[i] : cc[k]; s[k * 12 + r] = silu_f(v); }
    __syncthreads();
    for (int item = item0; item < NMOD / 32; item += gridDim.x) {
        if (item != item0) { const float* wp = wm + (size_t)(kg * 64) * NMOD + item * 32 + (t & 31);
#pragma unroll
            for (int k = 0; k < 64; ++k) w[k] = __builtin_nontemporal_load(wp + (size_t)k * NMOD); }
        float acc[9];
#pragma unroll
        for (int r = 0; r < 9; ++r) acc[r] = 0.f;
#pragma unroll
        for (int k = 0; k < 64; ++k) {
            const float* sp = s + (kg * 64 + k) * 12; const f32x4 s0 = *(const f32x4*)sp, s1 = *(const f32x4*)(sp + 4); const float s8 = sp[8];
            acc[0] += s0.x * w[k]; acc[1] += s0.y * w[k]; acc[2] += s0.z * w[k]; acc[3] += s0.w * w[k];
            acc[4] += s1.x * w[k]; acc[5] += s1.y * w[k]; acc[6] += s1.z * w[k]; acc[7] += s1.w * w[k]; acc[8] += s8 * w[k];
        }
#pragma unroll
        for (int r = 0; r < 9; ++r) red[(kg * 9 + r) * 32 + (t & 31)] = acc[r];
        __syncthreads();
        if (t < 9 * 32) {
            const int r = t >> 5, cl = t & 31; float v = 0.f;
#pragma unroll
            for (int g = 0; g < 16; ++g) v += red[(g * 9 + r) * 32 + cl];
            __hip_atomic_store((unsigned*)MOD + r * NMOD + item * 32 + cl, __float_as_uint(v + bm[item * 32 + cl]), __ATOMIC_RELAXED, __HIP_MEMORY_SCOPE_AGENT);
        }
        __syncthreads();
        if (t == 0 && item < MOD_PRE_ITEMS) __hip_atomic_fetch_add((unsigned*)(a.ws + WS_PCNT) + 64 * 8, 1u, __ATOMIC_RELAXED, __HIP_MEMORY_SCOPE_AGENT);
    }
}
__device__ __forceinline__ void mod_pre_wait(const Args& a) {
    if (threadIdx.x == 0) {
        unsigned* cnt = (unsigned*)(a.ws + WS_PCNT) + 64 * 8; unsigned sp = 0;
        while (__hip_atomic_load(cnt, __ATOMIC_RELAXED, __HIP_MEMORY_SCOPE_AGENT) < (unsigned)MOD_PRE_ITEMS) { __builtin_amdgcn_s_sleep(1); if (++sp > (1u << 22)) break; }
        __builtin_amdgcn_fence(__ATOMIC_ACQUIRE, "agent");
        asm volatile("s_waitcnt vmcnt(0)" ::: "memory");
    }
    __syncthreads();
}

struct TItem { const float* W; int K, N, n0, k0, rowoff, gu; const float* kscale; float cs_lo; int cs_n; bf16_t* WT; };
typedef short wv4i16_t __attribute__((ext_vector_type(4)));
__device__ __forceinline__ void titem_load(const TItem& I, f32x4 (&r)[8], int lane) {
    const float* p = I.W + (size_t)(I.k0 + (lane >> 3)) * I.N + I.n0 + 4 * (lane & 7);
#pragma unroll
    for (int i = 0; i < 8; ++i) r[i] = __builtin_nontemporal_load((const f32x4*)(p + (size_t)(8 * i) * I.N));
}
template <bool KSC>
__device__ __forceinline__ void titem_store(const TItem& I, const f32x4 (&r)[8], unsigned scr, int lane) {
    float cs[4] = {1.f, 1.f, 1.f, 1.f};
    if (KSC) {
#pragma unroll
        for (int c = 0; c < 4; ++c) cs[c] = (I.n0 + 4 * (lane & 7) + c < I.cs_n) ? I.cs_lo : 1.f; }
#pragma unroll
    for (int i = 0; i < 8; ++i) {
        f32x4 v = r[i];
        if (KSC) { const float ks = I.kscale ? I.kscale[I.k0 + 8 * i + (lane >> 3)] : 1.f; v.x *= ks * cs[0]; v.y *= ks * cs[1]; v.z *= ks * cs[2]; v.w *= ks * cs[3]; }
        u32x2 w; w.x = cvtpk(v.x, v.y); w.y = cvtpk(v.z, v.w);
        asm volatile("ds_write_b64 %0, %1 offset:%c2" :: "v"(scr + lane * 8), "v"(w), "i"(i * 512) : "memory");
    }
    const int g = lane >> 4, li = lane & 15, c = g & 1;
    const unsigned ra = scr + ((li >> 2) * 64 + 32 * c + (li & 3) * 8) + (g >> 1) * 2048;
    wv4i16_t lo[4], hi[4];
    asm volatile("s_waitcnt lgkmcnt(0)" ::: "memory");
#pragma unroll
    for (int it = 0; it < 4; ++it)
        asm volatile("ds_read_b64_tr_b16 %0, %2 offset:%c3\n\tds_read_b64_tr_b16 %1, %2 offset:%c4" : "=&v"(lo[it]), "=&v"(hi[it]) : "v"(ra), "i"(it * 512), "i"(it * 512 + 256) : "memory");
    asm volatile("s_waitcnt lgkmcnt(0)" ::: "memory"); __builtin_amdgcn_sched_barrier(0);
    const int nn = I.n0 + 16 * c + li, orow = I.rowoff + (I.gu ? ((nn >> 7) * 256 + (nn & 127)) : nn);
    if (KSC) {
        bf16_t* op = I.WT + (size_t)orow * I.K + I.k0 + (g >> 1) * 32;
#pragma unroll
        for (int it = 0; it < 4; ++it) { const bf16x8 o = (bf16x8){lo[it][0], lo[it][1], lo[it][2], lo[it][3], hi[it][0], hi[it][1], hi[it][2], hi[it][3]}; *(bf16x8*)(op + 8 * it) = o; }
    } else {
        unsigned char* op = (unsigned char*)I.WT + (size_t)orow * I.K + I.k0 + (g >> 1) * 32;
#pragma unroll
        for (int it = 0; it < 4; ++it) {
            u32x2 o;
            o.x = cvt4_fp8(bf2f((bf16_t)lo[it][0]) * W8_SCALE, bf2f((bf16_t)lo[it][1]) * W8_SCALE, bf2f((bf16_t)lo[it][2]) * W8_SCALE, bf2f((bf16_t)lo[it][3]) * W8_SCALE);
            o.y = cvt4_fp8(bf2f((bf16_t)hi[it][0]) * W8_SCALE, bf2f((bf16_t)hi[it][1]) * W8_SCALE, bf2f((bf16_t)hi[it][2]) * W8_SCALE, bf2f((bf16_t)hi[it][3]) * W8_SCALE);
            *(u32x2*)(op + 8 * it) = o;
        }
    }
}
__device__ __forceinline__ void titem8_load(const TItem& I, f32x4 (&r)[8], int lane) {
    const float* p = I.W + (size_t)(I.k0 + 2 * (lane >> 3)) * I.N + I.n0 + 4 * (lane & 7);
#pragma unroll
    for (int i = 0; i < 4; ++i) { r[2 * i] = __builtin_nontemporal_load((const f32x4*)(p + (size_t)(16 * i) * I.N)); r[2 * i + 1] = __builtin_nontemporal_load((const f32x4*)(p + (size_t)(16 * i + 1) * I.N)); }
}
__device__ __forceinline__ float sc8(float v) { return __builtin_amdgcn_fmed3f(v * W8_SCALE, -448.f, 448.f); }
__device__ __forceinline__ unsigned char* titem8_outptr(const TItem& I, int lane) {
    const int g = lane >> 4, li = lane & 15, c = g & 1;
    const int nn = I.n0 + 16 * c + li, orow = I.rowoff + (I.gu ? ((nn >> 7) * 256 + (nn & 127)) : nn);
    return (unsigned char*)I.WT + (size_t)orow * I.K + I.k0 + (g >> 1) * 32;
}
__device__ __forceinline__ void titem8_store(unsigned char* op, const f32x4 (&r)[8], unsigned scr, int lane, bool doit = true) {
#pragma unroll
    for (int i = 0; i < 4; ++i) {
        const f32x4 ra = r[2 * i], rb = r[2 * i + 1];
        int w0 = __builtin_amdgcn_cvt_pk_fp8_f32(sc8(ra.x), sc8(rb.x), 0, false); w0 = __builtin_amdgcn_cvt_pk_fp8_f32(sc8(ra.y), sc8(rb.y), w0, true);
        int w1 = __builtin_amdgcn_cvt_pk_fp8_f32(sc8(ra.z), sc8(rb.z), 0, false); w1 = __builtin_amdgcn_cvt_pk_fp8_f32(sc8(ra.w), sc8(rb.w), w1, true);
        u32x2 w; w.x = (unsigned)w0; w.y = (unsigned)w1;
        asm volatile("ds_write_b64 %0, %1 offset:%c2" :: "v"(scr + lane * 8), "v"(w), "i"(i * 512) : "memory");
    }
    const int g = lane >> 4, li = lane & 15, c = g & 1;
    const unsigned ra_ = scr + ((li >> 2) * 64 + 32 * c + (li & 3) * 8) + (g >> 1) * 1024;
    wv4i16_t lo[2], hi[2];
    asm volatile("s_waitcnt lgkmcnt(0)" ::: "memory");
#pragma unroll
    for (int it = 0; it < 2; ++it)
        asm volatile("ds_read_b64_tr_b16 %0, %2 offset:%c3\n\tds_read_b64_tr_b16 %1, %2 offset:%c4" : "=&v"(lo[it]), "=&v"(hi[it]) : "v"(ra_), "i"(it * 512), "i"(it * 512 + 256) : "memory");
    asm volatile("s_waitcnt lgkmcnt(0)" ::: "memory"); __builtin_amdgcn_sched_barrier(0);
#pragma unroll
    for (int it = 0; it < 2; ++it) { const bf16x8 o = (bf16x8){lo[it][0], lo[it][1], lo[it][2], lo[it][3], hi[it][0], hi[it][1], hi[it][2], hi[it][3]}; if (doit) *(bf16x8*)(op + 16 * it) = o; }
}
constexpr int WI_IN = (DM / 64) * (DIN / 32), WI_OUT = (DM / 64) * (DM / 32), WI_G = (DM / 64) * (DE / 32), WI_D = (DE / 64) * (DM / 32);
constexpr int WI_DENSE = WI_IN + WI_OUT, WI_GU = NE * 2 * WI_G, WI_DN = NE * WI_D, WI_MOE = WI_GU + WI_DN;
#ifndef INPROJ_ITEMS_V
#define INPROJ_ITEMS_V 6144
#endif
constexpr int WI_SIDE = INPROJ_ITEMS_V;
constexpr int WI_MIX_END = WI_DENSE + WI_MOE - WI_SIDE;
__device__ __forceinline__ TItem wconv_item(const Args& a, int it) {
    bf16_t* WIN = (bf16_t*)(a.ws + WS_WIN); bf16_t* WOUT = (bf16_t*)(a.ws + WS_WOUT); bf16_t* W1 = (bf16_t*)(a.ws + WS_W1); bf16_t* W2 = (bf16_t*)(a.ws + WS_W2);
    TItem I; I.kscale = nullptr; I.cs_lo = 1.f; I.cs_n = 0; I.rowoff = 0; I.gu = 0;
    int r = it;
    if (r < WI_IN) { I.W = a.in[7]; I.K = DM; I.N = DIN; I.WT = WIN; I.cs_lo = QSCALE; I.cs_n = DNA; I.k0 = 64 * (r / (DIN / 32)); I.n0 = 32 * (r % (DIN / 32)); }
    else if ((r -= WI_IN) < WI_OUT) { I.W = a.in[14]; I.K = DM; I.N = DM; I.WT = WOUT; const int kb = r / (DM / 32); I.kscale = (kb * 64 < DNA) ? a.in[12] : (a.in[13] - DNA); I.k0 = 64 * kb; I.n0 = 32 * (r % (DM / 32)); }
    else { r -= WI_OUT;
        if (r < WI_GU) { const int e = r / (2 * WI_G); r -= e * (2 * WI_G); const int up = r / WI_G; r -= up * WI_G; I.W = (up ? a.in[18] : a.in[17]) + (size_t)e * DM * DE; I.K = DM; I.N = DE; I.WT = (bf16_t*)((unsigned char*)W1 + (size_t)e * 3072 * DM); I.gu = 1; I.rowoff = 128 * up; I.k0 = 64 * (r / (DE / 32)); I.n0 = 32 * (r % (DE / 32)); }
        else { r -= WI_GU; const int e = r / WI_D; r -= e * WI_D; I.W = a.in[19] + (size_t)e * DE * DM; I.K = DE; I.N = DM; I.WT = (bf16_t*)((unsigned char*)W2 + (size_t)e * DM * DE); I.k0 = 64 * (r / (DM / 32)); I.n0 = 32 * (r % (DM / 32)); } }
    return I;
}
__device__ __forceinline__ TItem wdown_item(const Args& a, int r) {
    TItem I; I.kscale = nullptr; I.cs_lo = 1.f; I.cs_n = 0; I.rowoff = 0; I.gu = 0;
    const int e = r / WI_D; r -= e * WI_D; I.W = a.in[19] + (size_t)e * DE * DM; I.K = DE; I.N = DM; I.WT = (bf16_t*)(a.ws + WS_W2 + (size_t)e * DM * DE); I.k0 = 64 * (r / (DM / 32)); I.n0 = 32 * (r % (DM / 32));
    return I;
}
template <bool KSC>
__device__ __forceinline__ void wconv_range(const Args& a, unsigned scr, int it, int last, int stride, int lane) {
    if (it >= last) return;
    f32x4 ra[8], rb[8];
    TItem Ia = wconv_item(a, it), Ib = Ia;
    if (KSC) titem_load(Ia, ra, lane); else titem8_load(Ia, ra, lane);
    for (; it < last; it += 2 * stride) {
        const bool hb = it + stride < last;
        if (hb) { Ib = wconv_item(a, it + stride); if (KSC) titem_load(Ib, rb, lane); else titem8_load(Ib, rb, lane); }
        if (KSC) titem_store<true>(Ia, ra, scr, lane); else titem8_store(titem8_outptr(Ia, lane), ra, scr, lane);
        if (!hb) break;
        const bool ha = it + 2 * stride < last;
        if (ha) { Ia = wconv_item(a, it + 2 * stride); if (KSC) titem_load(Ia, ra, lane); else titem8_load(Ia, ra, lane); }
        if (KSC) titem_store<true>(Ib, rb, scr, lane); else titem8_store(titem8_outptr(Ib, lane), rb, scr, lane);
        if (!ha) break;
    }
}
__device__ __forceinline__ void wconv_stream4(const Args& a, unsigned scr, int it, int last, int stride, int lane) {
    f32x4 r0[8], r1[8], r2[8], r3[8];
    if (it < last) titem8_load(wconv_item(a, it), r0, lane);
    if (it + stride < last) titem8_load(wconv_item(a, it + stride), r1, lane);
    if (it + 2 * stride < last) titem8_load(wconv_item(a, it + 2 * stride), r2, lane);
    if (it + 3 * stride < last) titem8_load(wconv_item(a, it + 3 * stride), r3, lane);
#define WCS_STEP(R, D) { const int i_ = it + (D) * stride; if (i_ >= last) break;                \
        { const TItem I = wconv_item(a, i_); titem8_store(titem8_outptr(I, lane), R, scr, lane); } \
        if (i_ + 4 * stride < last) titem8_load(wconv_item(a, i_ + 4 * stride), R, lane); }
    for (;; it += 4 * stride) { WCS_STEP(r0, 0) WCS_STEP(r1, 1) WCS_STEP(r2, 2) WCS_STEP(r3, 3) }
#undef WCS_STEP
}
__device__ __forceinline__ void phase_wconv(const Args& a, float* lds) {
    const int wave = __builtin_amdgcn_readfirstlane(threadIdx.x >> 6), lane = threadIdx.x & 63;
    wconv_range<true>(a, (unsigned)(size_t)(__attribute__((address_space(3))) unsigned char*)(lds) + 65536 + wave * 4096, blockIdx.x * 8 + wave, WI_DENSE, gridDim.x * 8, lane);
}

__device__ __forceinline__ const float* prenorm_row(const Args& a, int m) { return (m < NTOK) ? a.in[0] + (size_t)m * DM : a.in[2] + (size_t)(m - NTOK) * DM; }
__device__ __forceinline__ void prenorm_one(bf16_t* H, int m, const f32x4 (&v)[4], const f32x4 (&ga)[4], const f32x4 (&gb)[4], int lane) {
    float s = 0.f;
#pragma unroll
    for (int j = 0; j < 4; ++j) s += (v[j].x * v[j].x + v[j].y * v[j].y) + (v[j].z * v[j].z + v[j].w * v[j].w);
    const float rstd = rsqrtf(wave_sum(s) * (1.f / DM) + EPS);
    u32x2* o = (u32x2*)(H + (size_t)m * DM) + lane;
#pragma unroll
    for (int j = 0; j < 4; ++j) { const f32x4 y = (v[j] * rstd) * ga[j] + gb[j]; u32x2 w; w.x = cvtpk(y.x, y.y); w.y = cvtpk(y.z, y.w); o[64 * j] = w; }
}
__device__ __forceinline__ void phase_prenorm(const Args& a) {
    const int wave = threadIdx.x >> 6, lane = threadIdx.x & 63;
    const int gw = blockIdx.x * 8 + wave, NGW = gridDim.x * 8;
    const float* MOD = (const float*)(a.ws + WS_MOD); bf16_t* H = (bf16_t*)(a.ws + WS_H);
    const f32x4* n1 = (const f32x4*)a.in[6] + lane;
    const int NR = NTOK + NCTX, per = (NR + NGW - 1) / NGW, mbeg = gw * per, mend = (mbeg + per < NR) ? mbeg + per : NR;
    int mrcur = -1; f32x4 ga[4], gb[4];
    for (int m = mbeg; m < mend; m += 3) {
        const int nrow = (mend - m < 3) ? (mend - m) : 3;
        f32x4 v[3][4];
#pragma unroll
        for (int r = 0; r < 3; ++r) if (r < nrow) { const f32x4* xr = (const f32x4*)prenorm_row(a, m + r) + lane;
#pragma unroll
            for (int j = 0; j < 4; ++j) v[r][j] = __builtin_nontemporal_load(xr + 64 * j); }
#pragma unroll
        for (int r = 0; r < 3; ++r) if (r < nrow) {
            const int mm = m + r, mr = (mm < NTOK) ? mm / SEQ : 8;
            if (mr != mrcur) {
                const f32x4* sh = (const f32x4*)(MOD + mr * NMOD) + lane; const f32x4* sc = (const f32x4*)(MOD + mr * NMOD + DM) + lane;
#pragma unroll
                for (int j = 0; j < 4; ++j) { ga[j] = n1[64 * j] * (sc[64 * j] + 1.f); gb[j] = sh[64 * j]; }
                mrcur = mr;
            }
            prenorm_one(H, mm, v[r], ga, gb, lane);
        }
    }
}

__device__ __forceinline__ void norm2_blocks(const Args& a, float* lds, int blk0, int blk1, int bstride) {
    const int tid = threadIdx.x, wave = tid >> 6, lane = tid & 63, e = lane & 15, kq = lane >> 4;
    const float* MOD = (const float*)(a.ws + WS_MOD); unsigned char* H8 = a.ws + WS_H2; float* AFF = (float*)(a.ws + WS_AFF);
    float* ybuf = lds;
    float* part = lds + 16 * 1028;
    constexpr int YP = 1028;
    float wreg[32];
    {   const float* wp = a.in[16] + (size_t)(128 * wave + 4 * kq) * NE + e;
#pragma unroll
        for (int j = 0; j < 8; ++j)
#pragma unroll
            for (int i = 0; i < 4; ++i) wreg[4 * j + i] = wp[(16 * j + i) * NE]; }
    const f32x4* n2 = (const f32x4*)a.in[15] + lane;
    const bf16_t* XNB = (const bf16_t*)(a.ws + WS_XNB);
    for (int blk = blk0; blk < blk1; blk += bstride) {
        const int row0 = blk * 64, b = row0 / SEQ;
        f32x4 ga[4], gb[4];
        {   const f32x4* sh = (const f32x4*)(MOD + b * NMOD + 3 * DM) + lane; const f32x4* sc = (const f32x4*)(MOD + b * NMOD + 4 * DM) + lane;
#pragma unroll
            for (int j = 0; j < 4; ++j) { ga[j] = n2[64 * j] * (sc[64 * j] + 1.f); gb[j] = sh[64 * j]; } }
        u32x2 vn[2][4];
#pragma unroll
        for (int r = 0; r < 2; ++r) { const u32x2* xr = (const u32x2*)(XNB + (size_t)(row0 + 8 * r + wave) * DM) + lane;
#pragma unroll
            for (int j = 0; j < 4; ++j) vn[r][j] = xr[64 * j]; }
        for (int t = 0; t < 4; ++t) {
            f32x4 v[2][4];
#pragma unroll
            for (int r = 0; r < 2; ++r)
#pragma unroll
                for (int j = 0; j < 4; ++j) v[r][j] = (f32x4){bflo(vn[r][j].x), bfhi(vn[r][j].x), bflo(vn[r][j].y), bfhi(vn[r][j].y)};
            if (t + 1 < 4) {
#pragma unroll
                for (int r = 0; r < 2; ++r) { const u32x2* xr = (const u32x2*)(XNB + (size_t)(row0 + 16 * (t + 1) + 8 * r + wave) * DM) + lane;
#pragma unroll
                    for (int j = 0; j < 4; ++j) vn[r][j] = xr[64 * j]; } }
#pragma unroll
            for (int r = 0; r < 2; ++r) {
                const int m = row0 + 16 * t + 8 * r + wave;
                float s = 0.f;
#pragma unroll
                for (int j = 0; j < 4; ++j) s += (v[r][j].x * v[r][j].x + v[r][j].y * v[r][j].y) + (v[r][j].z * v[r][j].z + v[r][j].w * v[r][j].w);
                const float rstd = rsqrtf(wave_sum(s) * (1.f / DM) + EPS);
                unsigned* o = (unsigned*)(H8 + (size_t)m * DM) + lane;
#pragma unroll
                for (int j = 0; j < 4; ++j) {
                    const f32x4 y = (v[r][j] * rstd) * ga[j] + gb[j];
                    o[64 * j] = cvt4_fp8(y.x * A8_SCALE, y.y * A8_SCALE, y.z * A8_SCALE, y.w * A8_SCALE);
                    *((f32x4*)(ybuf + (8 * r + wave) * YP) + 64 * j + lane) = y;
                }
            }
            LDS_BARRIER();
            {
                f32x4 D0 = (f32x4){0.f, 0.f, 0.f, 0.f}, D1 = D0;
                const float* yp = ybuf + e * YP + 128 * wave + 4 * kq;
#pragma unroll
                for (int j = 0; j < 8; ++j) { const f32x4 y4 = *(const f32x4*)(yp + 16 * j);
                    D0 = __builtin_amdgcn_mfma_f32_16x16x4f32(wreg[4 * j + 0], y4.x, D0, 0, 0, 0); D1 = __builtin_amdgcn_mfma_f32_16x16x4f32(wreg[4 * j + 1], y4.y, D1, 0, 0, 0);
                    D0 = __builtin_amdgcn_mfma_f32_16x16x4f32(wreg[4 * j + 2], y4.z, D0, 0, 0, 0); D1 = __builtin_amdgcn_mfma_f32_16x16x4f32(wreg[4 * j + 3], y4.w, D1, 0, 0, 0); }
                *(f32x4*)(part + ((lane & 15) * 8 + wave) * 16 + 4 * kq) = D0 + D1;
            }
            LDS_BARRIER();
            if (tid < 256) {
                const int rr = tid >> 4;
                float lg = 0.f;
#pragma unroll
                for (int w = 0; w < 8; ++w) lg += part[(rr * 8 + w) * 16 + e];
                float mx = lg;
#pragma unroll
                for (int o2 = 1; o2 < 16; o2 <<= 1) mx = fmaxf(mx, __shfl_xor(mx, o2));
                const float ex = __expf(lg - mx); float den = ex;
#pragma unroll
                for (int o2 = 1; o2 < 16; o2 <<= 1) den += __shfl_xor(den, o2);
                const int n = (row0 + 16 * t + rr) % SEQ;
                __hip_atomic_store((unsigned*)AFF + ((size_t)b * NE + e) * SEQ + n, __float_as_uint(ex / den), __ATOMIC_RELAXED, __HIP_MEMORY_SCOPE_AGENT);
            }
        }
        LDS_BARRIER();
    }
}

__device__ __forceinline__ void phase_norm2(const Args& a, float* lds) { norm2_blocks(a, lds, blockIdx.x, NTOK / 64, gridDim.x); }

__device__ __forceinline__ int wave_incl_scan(int v, int lane) {
#pragma unroll
    for (int o = 1; o < 64; o <<= 1) { const int u = __shfl_up(v, o); if (lane >= o) v += u; }
    return v;
}
__device__ __forceinline__ void topk_items(const Args& a, float* lds, int item0, int item1, int istride) {
    const int t = threadIdx.x, wave = t >> 6, lane = t & 63;
    const float* AFF = (const float*)(a.ws + WS_AFF); float* GATE = (float*)(a.ws + WS_GATE); int* SEL = (int*)(a.ws + WS_SEL);
    int* IDX = (int*)(a.ws + WS_IDX);
    int* cntw = (int*)lds;
    int* wtot = (int*)(lds + 384);
    int* list = (int*)(lds + 320);
    int* cnt = (int*)(lds + 320 + 256);
    for (int item = item0; item < item1; item += istride) {
        const int half = item & 1, e = (item >> 1) & 15, b = item >> 5;
        const u32x4 k4 = ((const u32x4*)(AFF + ((size_t)b * NE + e) * SEQ))[t];
        unsigned prefix = 0u;
        for (int rnd = 0; rnd < 16; ++rnd) {
            const int lo = 29 - 2 * rnd;
            const unsigned b1 = (lo >= 0) ? (1u << lo) : 0u, b2 = (lo >= 0) ? (2u << lo) : 1u;
            const unsigned c1 = prefix | b1, c2 = prefix | b2, c3 = prefix | b1 | b2;
            int n1 = __builtin_popcountll(__ballot(k4.x >= c1)) + __builtin_popcountll(__ballot(k4.y >= c1)) + __builtin_popcountll(__ballot(k4.z >= c1)) + __builtin_popcountll(__ballot(k4.w >= c1));
            int n2 = __builtin_popcountll(__ballot(k4.x >= c2)) + __builtin_popcountll(__ballot(k4.y >= c2)) + __builtin_popcountll(__ballot(k4.z >= c2)) + __builtin_popcountll(__ballot(k4.w >= c2));
            int n3 = __builtin_popcountll(__ballot(k4.x >= c3)) + __builtin_popcountll(__ballot(k4.y >= c3)) + __builtin_popcountll(__ballot(k4.z >= c3)) + __builtin_popcountll(__ballot(k4.w >= c3));
            if (lane == 0) { cntw[(rnd * 3 + 0) * 8 + wave] = n1; cntw[(rnd * 3 + 1) * 8 + wave] = n2; cntw[(rnd * 3 + 2) * 8 + wave] = n3; }
            __syncthreads();
            int t1 = 0, t2 = 0, t3 = 0;
#pragma unroll
            for (int w = 0; w < 8; ++w) { t1 += cntw[(rnd * 3 + 0) * 8 + w]; t2 += cntw[(rnd * 3 + 1) * 8 + w]; t3 += cntw[(rnd * 3 + 2) * 8 + w]; }
            if (lo >= 0) prefix = (t3 >= CAP) ? c3 : ((t2 >= CAP) ? c2 : ((t1 >= CAP) ? c1 : prefix));
            else prefix = (t2 >= CAP) ? c2 : prefix;
        }
        const unsigned T = prefix;
        const int g0 = k4.x > T, g1 = k4.y > T, g2 = k4.z > T, g3 = k4.w > T;
        const int e0 = k4.x == T, e1 = k4.y == T, e2 = k4.z == T, e3 = k4.w == T;
        const int cg = g0 + g1 + g2 + g3, ce = e0 + e1 + e2 + e3;
        const int sg = wave_incl_scan(cg, lane), se = wave_incl_scan(ce, lane);
        if (lane == 63) { wtot[wave] = sg; wtot[8 + wave] = se; }
        __syncthreads();
        int gbase = 0, ebase = 0, ngt = 0;
#pragma unroll
        for (int w = 0; w < 8; ++w) { const int x = wtot[w], y = wtot[8 + w]; ngt += x; if (w < wave) { gbase += x; ebase += y; } }
        int gpos = gbase + sg - cg, epos = ebase + se - ce; const int need = CAP - ngt;
        int sl[4];
        sl[0] = g0 ? gpos : ((e0 && epos < need) ? ngt + epos : -1); gpos += g0; epos += e0;
        sl[1] = g1 ? gpos : ((e1 && epos < need) ? ngt + epos : -1); gpos += g1; epos += e1;
        sl[2] = g2 ? gpos : ((e2 && epos < need) ? ngt + epos : -1); gpos += g2; epos += e2;
        sl[3] = g3 ? gpos : ((e3 && epos < need) ? ngt + epos : -1);
        if ((t >> 8) == half) {
            const unsigned kk[4] = {k4.x, k4.y, k4.z, k4.w};
#pragma unroll
            for (int i = 0; i < 4; ++i) {
                const int n = 4 * t + i;
                SEL[((size_t)b * SEQ + n) * NE + e] = sl[i];
                if (sl[i] >= 0) { GATE[(b * NE + e) * CAP + sl[i]] = __uint_as_float(kk[i]); IDX[(e * NB + b) * CAP + sl[i]] = b * SEQ + n; }
            }
        }
        __syncthreads();
    }
}

__device__ __forceinline__ void phase_topk(const Args& a, float* lds) { topk_items(a, lds, blockIdx.x, NB * NE * 2, gridDim.x); }
__device__ __forceinline__ void phase_norm2_topk(const Args& a, float* lds) {
    const int blk = blockIdx.x, b = blk >> 5;
    norm2_blocks(a, lds, blk, blk + 1, 1);
    asm volatile("s_waitcnt vmcnt(0)" ::: "memory");
    LDS_BARRIER();
    if (threadIdx.x == 0) {
        unsigned* cnt = (unsigned*)(a.ws + WS_PCNT) + 64 * b;
        __hip_atomic_fetch_add(cnt, 1u, __ATOMIC_RELAXED, __HIP_MEMORY_SCOPE_AGENT);
        unsigned sp = 0;
        while (__hip_atomic_load(cnt, __ATOMIC_RELAXED, __HIP_MEMORY_SCOPE_AGENT) < 32u) { __builtin_amdgcn_s_sleep(1); if (++sp > (1u << 22)) break; }
        __builtin_amdgcn_fence(__ATOMIC_ACQUIRE, "agent");
        asm volatile("s_waitcnt vmcnt(0)" ::: "memory");
    }
    LDS_BARRIER();
    const int item = b * 32 + (blk & 31);
    topk_items(a, lds, item, item + 1, 1);
}

__device__ __forceinline__ void final_gather(const Args& a, int m, int mysel, f32x4 (&acc)[4], int lane) {
    const unsigned char* Y = a.ws + WS_Y; const int b = m / SEQ;
#pragma unroll
    for (int j = 0; j < 4; ++j) acc[j] = (f32x4){0.f, 0.f, 0.f, 0.f};
    unsigned long long msk = __ballot(mysel >= 0);
    while (msk) {
        const int e = __builtin_ctzll(msk); msk &= msk - 1;
        const int sl = __shfl(mysel, e);
        const unsigned* yr = (const unsigned*)(Y + (size_t)((e * NB + b) * CAP + sl) * DM) + lane;
#pragma unroll
        for (int j = 0; j < 4; ++j) { const unsigned w = yr[64 * j]; const f32x2 lo = __builtin_amdgcn_cvt_pk_f32_fp8((int)w, false), hi = __builtin_amdgcn_cvt_pk_f32_fp8((int)w, true);
            acc[j].x += lo.x; acc[j].y += lo.y; acc[j].z += hi.x; acc[j].w += hi.y; }
    }
#pragma unroll
    for (int j = 0; j < 4; ++j) acc[j] = acc[j] * (1.f / Y8_SCALE);
}
__device__ __forceinline__ void final_finish(const Args& a, float* dst, int m, const f32x4 (&xv)[4], const f32x4 (&acc)[4], int lane) {
    const float* MOD = (const float*)(a.ws + WS_MOD); const int b = m / SEQ;
    const f32x4* nf = (const f32x4*)a.in[20] + lane; const f32x4* g2 = (const f32x4*)(MOD + b * NMOD + 5 * DM) + lane;
    f32x4* xr = (f32x4*)(dst + (size_t)m * DM) + lane;
    f32x4 v[4]; float s = 0.f;
#pragma unroll
    for (int j = 0; j < 4; ++j) { v[j] = xv[j] + g2[64 * j] * acc[j]; s += (v[j].x * v[j].x + v[j].y * v[j].y) + (v[j].z * v[j].z + v[j].w * v[j].w); }
    const float rstd = rsqrtf(wave_sum(s) * (1.f / DM) + EPS);
#pragma unroll
    for (int j = 0; j < 4; ++j) __builtin_nontemporal_store((v[j] * rstd) * nf[64 * j], xr + 64 * j);
}
__device__ __forceinline__ void phase_final(const Args& a, float* dst) {
    const int wave = threadIdx.x >> 6, lane = threadIdx.x & 63;
    const int gw = blockIdx.x * 8 + wave, NGW = gridDim.x * 8;
    const int* SEL = (const int*)(a.ws + WS_SEL);
    const int per = (NTOK + NGW - 1) / NGW, mbeg = gw * per, mend = (mbeg + per < NTOK) ? mbeg + per : NTOK;
    for (int m = mbeg; m < mend; m += 3) {
        const int m2 = m + 1, m3 = m + 2; const bool two = m2 < mend, three = m3 < mend;
        const int s0 = (lane < NE) ? SEL[(size_t)m * NE + lane] : -1;
        const int s1 = (two && lane < NE) ? SEL[(size_t)m2 * NE + lane] : -1;
        const int s2 = (three && lane < NE) ? SEL[(size_t)m3 * NE + lane] : -1;
        f32x4 x0[4], x1[4], x2[4], a0[4], a1[4], a2[4];
        { const u32x2* xr = (const u32x2*)((const bf16_t*)(a.ws + WS_XNB) + (size_t)m * DM) + lane;
#pragma unroll
          for (int j = 0; j < 4; ++j) { const u32x2 w = xr[64 * j]; x0[j] = (f32x4){bflo(w.x), bfhi(w.x), bflo(w.y), bfhi(w.y)}; } }
        if (two) { const u32x2* xr = (const u32x2*)((const bf16_t*)(a.ws + WS_XNB) + (size_t)m2 * DM) + lane;
#pragma unroll
          for (int j = 0; j < 4; ++j) { const u32x2 w = xr[64 * j]; x1[j] = (f32x4){bflo(w.x), bfhi(w.x), bflo(w.y), bfhi(w.y)}; } }
        if (three) { const u32x2* xr = (const u32x2*)((const bf16_t*)(a.ws + WS_XNB) + (size_t)m3 * DM) + lane;
#pragma unroll
          for (int j = 0; j < 4; ++j) { const u32x2 w = xr[64 * j]; x2[j] = (f32x4){bflo(w.x), bfhi(w.x), bflo(w.y), bfhi(w.y)}; } }
        final_gather(a, m, s0, a0, lane);
        if (two) final_gather(a, m2, s1, a1, lane);
        if (three) final_gather(a, m3, s2, a2, lane);
        final_finish(a, dst, m, x0, a0, lane);
        if (two) final_finish(a, dst, m2, x1, a1, lane);
        if (three) final_finish(a, dst, m3, x2, a2, lane);
    }
}

namespace pg8 {
#define PG8_LAS __attribute__((address_space(3)))
typedef unsigned short bf16_t;
typedef short bf16x8 __attribute__((ext_vector_type(8)));
typedef float f32x4 __attribute__((ext_vector_type(4)));
typedef unsigned u32x4 __attribute__((ext_vector_type(4)));
typedef int v4i_t __attribute__((ext_vector_type(4)));
typedef int v8i_t __attribute__((ext_vector_type(8)));
constexpr int BM = 256, BK = 64, HALF = 128, HTB = HALF * BK * 2  , STAGE_BYTES = 8 * HTB, NXCD = 8, WGM = 8;

__host__ __device__ __forceinline__ int lds_byte(int r, int c) { const int st = (r >> 4) * 2 + (c >> 5), rr = r & 15, cc = c & 31, ob = rr * 64 + cc * 2; return st * 1024 + (ob ^ (((ob >> 9) & 1) << 5)); }
__host__ __device__ __forceinline__ void stage_rc(int b, int& R, int& C) { const int st = b / 1024, sb = b % 1024, swz = sb ^ (((sb >> 9) & 1) << 5); R = (st >> 1) * 16 + swz / 64; C = (st & 1) * 32 + (swz % 64) / 2; }
__host__ __device__ __forceinline__ int perm32(int rho) { const int n = rho >> 4, i = rho & 15; return 8 * (i >> 2) + 4 * n + (i & 3); }

struct Unit { int pm, pn; };
struct Gemm { const bf16_t* A; const bf16_t* Bt; int M, N, K; const int* gidx; };
struct HostW { const Args* a; int first, stride, last; unsigned scr; };
template <class Epi, class Sched, bool ALIGN_EPI = false, bool SP2 = false, bool GATHER = false, bool F8 = false, bool HOST = false>
__device__ __forceinline__ void gemm_phase(PG8_LAS unsigned char* lds, const Gemm g, const Sched& S, const Epi& E, const HostW hw = HostW{nullptr, 0, 0, 0, 0u}) {
    const int tid = threadIdx.x, wid = __builtin_amdgcn_readfirstlane(tid >> 6), lane = tid & 63, wr = wid >> 2, wc = wid & 3, fr = lane & 15, fq = lane >> 4;
    const int K = g.K, nt = K / BK;
    unsigned voffA[2], voffB[2];
#pragma unroll
    for (int i = 0; i < 2; ++i) { int R, C; stage_rc(tid * 16 + i * 8192, R, C); const int Rb = Epi::PERM ? ((R & ~31) + perm32(R & 31)) : R;
        voffA[i] = (unsigned)(R * K + C) * 2u; voffB[i] = (unsigned)(Rb * K + C) * 2u; }
    const size_t kstep = (size_t)(BK * 2);
    const size_t hstep = (size_t)HALF * K * 2;
    const size_t tstep = 2 * hstep;
    const unsigned ldsw = (unsigned)wid * 1024u;
    const int aoff = lds_byte(wr * 64 + fr, fq * 8), boff = lds_byte(wc * 32 + fr, fq * 8);
    const int sc8 = 0x7F7F7F7F;
    constexpr int KSTEP_B = 1024;
#define PG8_SA(b, h) (((b) * 2 + (h)) * HTB)
#define PG8_SB(b, h) ((4 + (b) * 2 + (h)) * HTB)
#define PG8_STAGE(bufoff, gbase, voff) do { _Pragma("unroll") for (int _i = 0; _i < 2; ++_i) \
        __builtin_amdgcn_global_load_lds((const unsigned*)((const char*)(gbase) + (voff)[_i]), (PG8_LAS unsigned*)(lds + (bufoff) + ldsw + _i * 8192), 16, 0, 0); } while (0)
    unsigned vAc[2][2], vAn[2][2], vA2[2][2];
#define PG8_GIDX(dst, pm_) do { _Pragma("unroll") for (int _h = 0; _h < 2; ++_h) _Pragma("unroll") for (int _i = 0; _i < 2; ++_i) { int R_, C_; stage_rc(tid * 16 + _i * 8192, R_, C_); \
        dst[_h][_i] = (unsigned)(g.gidx[(pm_) * BM + _h * HALF + R_] * K + C_) * 2u; } } while (0)
#define PG8_STAGEA(bufoff, base, h, vsel) do { if constexpr (GATHER) { PG8_STAGE(bufoff, base, vsel[h]); } else { PG8_STAGE(bufoff, (base) + (h) * hstep, voffA); } } while (0)
#define PG8_LDA(dst, b, h) do { _Pragma("unroll") for (int m = 0; m < 4; ++m) _Pragma("unroll") for (int k = 0; k < 2; ++k) dst[m][k] = *(const PG8_LAS bf16x8*)(lds + PG8_SA(b, h) + aoff + m * 2048 + k * KSTEP_B); } while (0)
#define PG8_LDB(dst, b, h) do { _Pragma("unroll") for (int n = 0; n < 2; ++n) _Pragma("unroll") for (int k = 0; k < 2; ++k) dst[n][k] = *(const PG8_LAS bf16x8*)(lds + PG8_SB(b, h) + boff + n * 2048 + k * KSTEP_B); } while (0)
#define PG8_CAT8(x, y) __builtin_shufflevector(__builtin_bit_cast(v4i_t, x), __builtin_bit_cast(v4i_t, y), 0, 1, 2, 3, 4, 5, 6, 7)
#define PG8_MMA(ai, bj, At, Bt) do { __builtin_amdgcn_s_setprio(1); _Pragma("unroll") for (int m = 0; m < 4; ++m) _Pragma("unroll") for (int n = 0; n < 2; ++n) { \
        if constexpr (F8) { const v8i_t b8_ = PG8_CAT8(Bt[n][0], Bt[n][1]), a8_ = PG8_CAT8(At[m][0], At[m][1]); \
            asm volatile("s_nop 1\n\tv_mfma_scale_f32_16x16x128_f8f6f4 %0, %1, %2, %0, %3, %3 op_sel_hi:[0,0,0]" : "+v"(acc[ai][bj][m][n]) : "v"(b8_), "v"(a8_), "v"(sc8)); } \
        else { _Pragma("unroll") for (int k = 0; k < 2; ++k) acc[ai][bj][m][n] = __builtin_amdgcn_mfma_f32_16x16x32_bf16(Bt[n][k], At[m][k], acc[ai][bj][m][n], 0, 0, 0); } } __builtin_amdgcn_s_setprio(0); } while (0)
#define PG8_WAIT_V(n) asm volatile("s_waitcnt vmcnt(" #n ")" ::: "memory")
#define PG8_WAIT_L(n) asm volatile("s_waitcnt lgkmcnt(" #n ")" ::: "memory")
#define PG8_BAR __builtin_amdgcn_s_barrier()
#define PG8_SCHED __builtin_amdgcn_sched_barrier(0)
    Unit cur, nxt; int ui = 0;
    if (!S.next(0, cur)) return;
    f32x4 acc[2][2][4][2];
#pragma unroll
    for (int a = 0; a < 2; ++a)
#pragma unroll
        for (int b = 0; b < 2; ++b)
#pragma unroll
            for (int m = 0; m < 4; ++m)
#pragma unroll
                for (int n = 0; n < 2; ++n) acc[a][b][m][n] = (f32x4){0.f, 0.f, 0.f, 0.f};
    bf16x8 At[4][2], B0[2][2], B1[2][2];
    const char* cA = (const char*)g.A + (GATHER ? (size_t)0 : (size_t)cur.pm * tstep); const char* cB = (const char*)g.Bt + (size_t)cur.pn * tstep;
    if constexpr (GATHER) { PG8_GIDX(vAc, cur.pm); }
    S.a_ready(cur);
    if constexpr (Epi::MIDSCALE) E.unit_begin(cur, ui, tid);
    if constexpr (SP2) {
        PG8_STAGE(PG8_SB(0, 0), cB, voffB); PG8_STAGE(PG8_SB(0, 1), cB + hstep, voffB); PG8_STAGEA(PG8_SA(0, 0), cA, 0, vAc); PG8_STAGEA(PG8_SA(0, 1), cA, 1, vAc);
        if (wr == 1) PG8_BAR;
        PG8_WAIT_V(2); PG8_BAR;
        PG8_STAGE(PG8_SB(1, 0), cB + kstep, voffB); PG8_STAGEA(PG8_SA(1, 0), cA + kstep, 0, vAc); PG8_STAGE(PG8_SB(1, 1), cB + hstep + kstep, voffB);
        PG8_WAIT_V(6); PG8_BAR;
    } else {
        PG8_STAGE(PG8_SB(0, 0), cB, voffB); PG8_STAGE(PG8_SA(0, 0), cA, voffA); PG8_STAGE(PG8_SB(0, 1), cB + hstep, voffB); PG8_STAGE(PG8_SA(0, 1), cA + hstep, voffA);
        if (wr == 1) PG8_BAR;
        PG8_WAIT_V(4); PG8_BAR;
        PG8_STAGE(PG8_SB(1, 0), cB + kstep, voffB); PG8_STAGE(PG8_SA(1, 0), cA + kstep, voffA); PG8_STAGE(PG8_SB(1, 1), cB + hstep + kstep, voffB);
        PG8_WAIT_V(6); PG8_BAR;
    }
    for (;;) {
        const bool has_next = S.next(ui + 1, nxt);
        const char* nA = (has_next && !GATHER) ? (const char*)g.A + (size_t)nxt.pm * tstep : cA; const char* nB = has_next ? (const char*)g.Bt + (size_t)nxt.pn * tstep : cB;
        if constexpr (GATHER) { if (has_next) { PG8_GIDX(vAn, nxt.pm); } else {
#pragma unroll
            for (int _h = 0; _h < 2; ++_h) { vAn[_h][0] = vAc[_h][0]; vAn[_h][1] = vAc[_h][1]; } } }
        for (int t = 0; t < nt; t += 2) {
            const bool last = (t == nt - 2);
            const char* a1 = cA + (size_t)(t + 1) * kstep;
            const char* a2 = last ? nA : cA + (size_t)(t + 2) * kstep; const char* b2 = last ? nB : cB + (size_t)(t + 2) * kstep;
            const char* a3 = a2 + kstep; const char* b3 = b2 + kstep;
            if (last && has_next) S.a_ready(nxt);
            if constexpr (GATHER) {
#pragma unroll
                for (int _h = 0; _h < 2; ++_h) { vA2[_h][0] = last ? vAn[_h][0] : vAc[_h][0]; vA2[_h][1] = last ? vAn[_h][1] : vAc[_h][1]; } }
            if constexpr (Epi::MIDSCALE) { if (t == nt / 2) E.midscale(acc, cur, ui, wr, fr); }
            if constexpr (SP2) {
            PG8_LDB(B0, 0, 0); PG8_LDB(B1, 0, 1); PG8_SCHED; PG8_LDA(At, 0, 0); PG8_STAGEA(PG8_SA(1, 1), a1, 1, vAc);
            PG8_WAIT_V(8); PG8_WAIT_L(0); PG8_BAR; PG8_MMA(0, 0, At, B0); PG8_MMA(0, 1, At, B1); PG8_BAR; PG8_SCHED;
            PG8_LDA(At, 0, 1); PG8_STAGE(PG8_SB(0, 0), b2, voffB); PG8_STAGE(PG8_SB(0, 1), b2 + hstep, voffB); PG8_STAGEA(PG8_SA(0, 0), a2, 0, vA2);
            PG8_WAIT_V(8); PG8_WAIT_L(0); PG8_BAR; PG8_MMA(1, 0, At, B0); PG8_MMA(1, 1, At, B1); PG8_BAR; PG8_SCHED;
            PG8_LDB(B0, 1, 0); PG8_LDB(B1, 1, 1); PG8_SCHED; PG8_LDA(At, 1, 0); PG8_STAGEA(PG8_SA(0, 1), a2, 1, vA2);
            PG8_WAIT_V(8); PG8_WAIT_L(0); PG8_BAR; PG8_MMA(0, 0, At, B0); PG8_MMA(0, 1, At, B1); PG8_BAR; PG8_SCHED;
            PG8_LDA(At, 1, 1); PG8_STAGE(PG8_SB(1, 0), b3, voffB); PG8_STAGE(PG8_SB(1, 1), b3 + hstep, voffB); PG8_STAGEA(PG8_SA(1, 0), a3, 0, vA2);
            PG8_WAIT_V(8); PG8_WAIT_L(0); PG8_BAR; PG8_MMA(1, 0, At, B0); PG8_MMA(1, 1, At, B1); PG8_BAR; PG8_SCHED;
            } else {
            PG8_LDB(B0, 0, 0); PG8_SCHED; PG8_LDA(At, 0, 0); PG8_STAGE(PG8_SA(1, 1), a1 + hstep, voffA);
            PG8_WAIT_L(8); PG8_BAR; PG8_WAIT_L(0); PG8_MMA(0, 0, At, B0); PG8_BAR; PG8_SCHED;
            PG8_LDB(B1, 0, 1); PG8_STAGE(PG8_SB(0, 0), b2, voffB);
            PG8_BAR; PG8_WAIT_L(0); PG8_MMA(0, 1, At, B1); PG8_BAR;
            PG8_LDA(At, 0, 1); PG8_STAGE(PG8_SA(0, 0), a2, voffA);
            PG8_BAR; PG8_WAIT_L(0); PG8_MMA(1, 0, At, B0); PG8_BAR; PG8_SCHED;
            PG8_STAGE(PG8_SB(0, 1), b2 + hstep, voffB);
            PG8_WAIT_V(6); PG8_BAR; PG8_MMA(1, 1, At, B1); PG8_BAR;
            PG8_LDB(B0, 1, 0); PG8_SCHED; PG8_LDA(At, 1, 0); PG8_STAGE(PG8_SA(0, 1), a2 + hstep, voffA);
            PG8_WAIT_L(8); PG8_BAR; PG8_WAIT_L(0); PG8_MMA(0, 0, At, B0); PG8_BAR; PG8_SCHED;
            PG8_LDB(B1, 1, 1); PG8_STAGE(PG8_SB(1, 0), b3, voffB);
            PG8_BAR; PG8_WAIT_L(0); PG8_MMA(0, 1, At, B1); PG8_BAR;
            PG8_LDA(At, 1, 1); PG8_STAGE(PG8_SA(1, 0), a3, voffA);
            PG8_BAR; PG8_WAIT_L(0); PG8_MMA(1, 0, At, B0); PG8_BAR; PG8_SCHED;
            PG8_STAGE(PG8_SB(1, 1), b3 + hstep, voffB);
            PG8_WAIT_V(6); PG8_BAR; PG8_MMA(1, 1, At, B1); PG8_BAR;
            }
        }
        if constexpr (ALIGN_EPI) { if (wr == 0) PG8_BAR; }
        if constexpr (F8) asm volatile("s_nop 15\n\ts_nop 7" ::: "memory");
        if constexpr (HOST) {
            E.part(acc, cur, wr, wc, fr, fq, 0);
            PG8_SCHED;
            ::f32x4 hr[8]; const int hit0 = hw.first + ui * hw.stride; const bool hhave = hit0 < hw.last; const int hit = hhave ? hit0 : hw.first;
            const TItem HI = wdown_item(*hw.a, hit); titem8_load(HI, hr, lane);
            PG8_SCHED;
            E.part(acc, cur, wr, wc, fr, fq, 1); S.done(cur);
            PG8_SCHED;
            titem8_store(titem8_outptr(HI, lane), hr, hw.scr, lane, hhave);
        } else
        if constexpr (!Epi::AFTER_DRAIN) { if constexpr (Epi::MIDSCALE) E.finish(acc, cur, ui, wr, wc, fr, fq); else E(acc, cur, wr, wc, fr, fq); S.done(cur); }
        if (!has_next) break;
#pragma unroll
        for (int a = 0; a < 2; ++a)
#pragma unroll
            for (int b = 0; b < 2; ++b)
#pragma unroll
                for (int m = 0; m < 4; ++m)
#pragma unroll
                    for (int n = 0; n < 2; ++n) acc[a][b][m][n] = (f32x4){0.f, 0.f, 0.f, 0.f};
        cur = nxt; cA = nA; cB = nB; ++ui;
        if constexpr (GATHER) {
#pragma unroll
            for (int _h = 0; _h < 2; ++_h) { vAc[_h][0] = vAn[_h][0]; vAc[_h][1] = vAn[_h][1]; } }
        if constexpr (Epi::MIDSCALE) E.unit_begin(cur, ui, tid);
        if constexpr (ALIGN_EPI) { if (wr == 1) PG8_BAR; }
    }
    PG8_WAIT_V(0);
    if constexpr (!ALIGN_EPI) { if (wr == 0) PG8_BAR; }
    PG8_BAR;
    if constexpr (Epi::AFTER_DRAIN) { E.fused(acc, cur, wr, wc, fr, fq, lds, wid, lane); S.done(cur); }
#undef PG8_SA
#undef PG8_SB
#undef PG8_STAGE
#undef PG8_STAGEA
#undef PG8_GIDX
#undef PG8_LDA
#undef PG8_LDB
#undef PG8_MMA
#undef PG8_CAT8
#undef PG8_WAIT_V
#undef PG8_WAIT_L
#undef PG8_BAR
#undef PG8_SCHED
}
}
namespace pg8 {
struct GroupedOrder {
    int nwg, npn, pn_grouped, G, c, nextra;
    __device__ __forceinline__ void init(int nwg_, int npn_, int pn_grouped_, int G_, int c_, int nextra_) { nwg = nwg_; npn = npn_; pn_grouped = pn_grouped_; G = G_; c = c_; nextra = nextra_; }
    __device__ __forceinline__ bool next(int i, Unit& u) const {
        const int L = i * G + c; if (L >= nwg + nextra) return false;
        if (L >= nwg) { const int x = L - nwg; u.pm = 64 + (x >> 2); u.pn = 2 + (x & 3); return true; }
        int wgid = L; { const int q = nwg / NXCD, r = nwg % NXCD, xcd = wgid % NXCD, off = wgid / NXCD; wgid = (xcd < r ? xcd * (q + 1) : r * (q + 1) + (xcd - r) * q) + off; }
        const int upg = 8 * npn, grp = wgid / upg, loc = wgid % upg;
        u.pm = grp * 8 + (loc & 7); u.pn = (pn_grouped ? grp * npn : 0) + (loc >> 3); return true;
    }
    __device__ __forceinline__ void a_ready(const Unit&) const {}
    __device__ __forceinline__ void done(const Unit&) const {}
};
__device__ __forceinline__ unsigned cvt_pk_bf16(float lo, float hi) { return ::cvtpk(lo, hi); }
__device__ __forceinline__ float gelu_fast(float x) { const float u = (-1.5957691216057308f * LOG2E) * (x + 0.044715f * x * x * x); return x * __builtin_amdgcn_rcpf(1.f + __builtin_amdgcn_exp2f(u)); }
__device__ __forceinline__ float silu_fast(float x) { return x * __builtin_amdgcn_rcpf(1.f + __builtin_amdgcn_exp2f(-LOG2E * x)); }

struct EpiInproj {
    static constexpr bool PERM = true, AFTER_DRAIN = false, MIDSCALE = false;
    bf16_t* Z; bf16_t* KVC;
    __device__ __forceinline__ void operator()(const f32x4 (&acc)[2][2][4][2], const Unit& u, int wr, int wc, int fr, int fq) const {
        const bool isctx = u.pm >= 64, act = (!isctx) && u.pn >= 6;
        bf16_t* base = isctx ? KVC : Z; const int ldc = isctx ? DM : DIN;
        const int row0 = (isctx ? (u.pm - 64) : u.pm) * BM + wr * 64 + fr, col0 = (isctx ? (u.pn - 2) : u.pn) * BM + wc * 32 + 8 * fq;
#pragma unroll
        for (int ai = 0; ai < 2; ++ai)
#pragma unroll
            for (int m = 0; m < 4; ++m) { bf16_t* rowp = base + (size_t)(row0 + ai * HALF + m * 16) * ldc + col0;
#pragma unroll
                for (int bj = 0; bj < 2; ++bj) { f32x4 v0 = acc[ai][bj][m][0], v1 = acc[ai][bj][m][1];
                    if (act) { v0 = (f32x4){gelu_fast(v0[0]), gelu_fast(v0[1]), gelu_fast(v0[2]), gelu_fast(v0[3])}; v1 = (f32x4){gelu_fast(v1[0]), gelu_fast(v1[1]), gelu_fast(v1[2]), gelu_fast(v1[3])}; }
                    u32x4 w; w.x = cvt_pk_bf16(v0[0], v0[1]); w.y = cvt_pk_bf16(v0[2], v0[3]); w.z = cvt_pk_bf16(v1[0], v1[1]); w.w = cvt_pk_bf16(v1[2], v1[3]);
                    *(u32x4*)(rowp + bj * HALF) = w; } }
    }
};
struct EpiOutproj {
    static constexpr bool PERM = false, AFTER_DRAIN = false, MIDSCALE = true;
    const float* x; bf16_t* out; const float* MOD; const float* SS; PG8_LAS float* tab;
    __device__ __forceinline__ void unit_begin(const Unit& u, int ui, int tid) const {
        if (tid < BM) { const f32x2 ss = *(const f32x2*)(SS + (size_t)(u.pm * BM + tid) * 2);
            const float ra = rsqrtf(ss.x * (1.f / 512.f) + EPS), rb = rsqrtf(ss.y * (1.f / 512.f) + EPS);
            PG8_LAS float* t = tab + ((ui & 1) * BM + tid) * 2; t[0] = ra / rb; t[1] = rb; }
    }
    __device__ __forceinline__ void midscale(f32x4 (&acc)[2][2][4][2], const Unit& u, int ui, int wr, int fr) const {
#pragma unroll
        for (int ai = 0; ai < 2; ++ai)
#pragma unroll
            for (int m = 0; m < 4; ++m) { const float r = tab[((ui & 1) * BM + ai * HALF + wr * 64 + m * 16 + fr) * 2];
#pragma unroll
                for (int bj = 0; bj < 2; ++bj)
#pragma unroll
                    for (int n = 0; n < 2; ++n) acc[ai][bj][m][n] = acc[ai][bj][m][n] * r; }
    }
    __device__ __forceinline__ void finish(const f32x4 (&acc)[2][2][4][2], const Unit& u, int ui, int wr, int wc, int fr, int fq) const {
        const int b = u.pm >> 3, col0 = u.pn * BM + wc * 32 + 4 * fq;
        f32x4 g1[2][2];
#pragma unroll
        for (int bj = 0; bj < 2; ++bj)
#pragma unroll
            for (int n = 0; n < 2; ++n) g1[bj][n] = *(const f32x4*)(MOD + b * NMOD + 2 * DM + col0 + bj * HALF + n * 16);
#pragma unroll
        for (int ai = 0; ai < 2; ++ai)
#pragma unroll
            for (int m = 0; m < 4; ++m) { const int r = ai * HALF + wr * 64 + m * 16 + fr; const float rb = tab[((ui & 1) * BM + r) * 2 + 1];
                const size_t off = (size_t)(u.pm * BM + r) * DM + col0;
#pragma unroll
                for (int bj = 0; bj < 2; ++bj)
#pragma unroll
                    for (int n = 0; n < 2; ++n) { const f32x4 xv = *(const f32x4*)(x + off + bj * HALF + n * 16); const f32x4 r = xv + g1[bj][n] * (acc[ai][bj][m][n] * rb); u32x2 w; w.x = cvt_pk_bf16(r[0], r[1]); w.y = cvt_pk_bf16(r[2], r[3]); *(u32x2*)(out + off + bj * HALF + n * 16) = w; } }
    }
};
struct EpiMoe1 {
    static constexpr bool PERM = true, AFTER_DRAIN = false, MIDSCALE = false;
    unsigned char* ACT;
    __device__ __forceinline__ void operator()(const f32x4 (&acc)[2][2][4][2], const Unit& u, int wr, int wc, int fr, int fq) const { part(acc, u, wr, wc, fr, fq, 0); part(acc, u, wr, wc, fr, fq, 1); }
    __device__ __forceinline__ void part(const f32x4 (&acc)[2][2][4][2], const Unit& u, int wr, int wc, int fr, int fq, const int ai) const {
        const int f0 = (u.pn % 12) * HALF + wc * 32 + 8 * fq;
        constexpr float SI = 1.f / (A8_SCALE * W8_SCALE);
        {
#pragma unroll
            for (int m = 0; m < 4; ++m) { unsigned char* rowp = ACT + (size_t)(u.pm * BM + ai * HALF + wr * 64 + m * 16 + fr) * DE + f0;
                const f32x4 g0 = acc[ai][0][m][0] * SI, g1 = acc[ai][0][m][1] * SI, u0 = acc[ai][1][m][0] * (SI * A8_SCALE), u1 = acc[ai][1][m][1] * (SI * A8_SCALE);
                u32x2 w; w.x = cvt4_fp8(silu_fast(g0[0]) * u0[0], silu_fast(g0[1]) * u0[1], silu_fast(g0[2]) * u0[2], silu_fast(g0[3]) * u0[3]);
                w.y = cvt4_fp8(silu_fast(g1[0]) * u1[0], silu_fast(g1[1]) * u1[1], silu_fast(g1[2]) * u1[2], silu_fast(g1[3]) * u1[3]);
                *(u32x2*)rowp = w; }
        }
    }
};
struct EpiMoe2 {
    static constexpr bool PERM = true, AFTER_DRAIN = false, MIDSCALE = false;
    unsigned char* Y; const float* GATE;
    __device__ __forceinline__ void operator()(const f32x4 (&acc)[2][2][4][2], const Unit& u, int wr, int wc, int fr, int fq) const {
        const int col0 = (u.pn & 3) * BM + wc * 32 + 8 * fq;
        const float* gp = GATE + ((u.pm & 7) * NE + (u.pm >> 3)) * CAP + wr * 64 + fr;
#pragma unroll
        for (int ai = 0; ai < 2; ++ai)
#pragma unroll
            for (int m = 0; m < 4; ++m) { const float gt = gp[ai * HALF + m * 16] * (Y8_SCALE / (A8_SCALE * W8_SCALE));
                unsigned char* rowp = Y + (size_t)(u.pm * BM + ai * HALF + wr * 64 + m * 16 + fr) * DM + col0;
#pragma unroll
                for (int bj = 0; bj < 2; ++bj) { const f32x4 v0 = acc[ai][bj][m][0] * gt, v1 = acc[ai][bj][m][1] * gt;
                    u32x2 w; w.x = cvt4_fp8(v0[0], v0[1], v0[2], v0[3]); w.y = cvt4_fp8(v1[0], v1[1], v1[2], v1[3]);
                    *(u32x2*)(rowp + bj * HALF) = w; } }
    }
};
}

#define LAS3 __attribute__((address_space(3)))
constexpr int RING_BYTES_C = 131072, LDS_TOP_C = 147456;
__device__ __forceinline__ void phase_inproj(const Args& a, LAS3 unsigned char* lds) {
    const int G = gridDim.x;
    const int wave = __builtin_amdgcn_readfirstlane(threadIdx.x >> 6), lane = threadIdx.x & 63;
    pg8::Gemm g{(const bf16_t*)(a.ws + WS_H), (const bf16_t*)(a.ws + WS_WIN), NTOK + NCTX, DIN, DM, nullptr};
    pg8::GroupedOrder S; S.init((NTOK / 256) * (DIN / 256), DIN / 256, 0, G, blockIdx.x, (NCTX / 256) * 4);
    pg8::EpiInproj E{(bf16_t*)(a.ws + WS_Z), (bf16_t*)(a.ws + WS_KVC)};
    pg8::gemm_phase<pg8::EpiInproj, pg8::GroupedOrder, true, true>(lds, g, S, E);
    const int nun = (NTOK / 256) * (DIN / 256) + (NCTX / 256) * 4, rounds = (nun + G - 1) / G, first_idle = nun - (rounds - 1) * G;
    const unsigned scr = (unsigned)(size_t)lds + wave * 4096;
    if (first_idle + 32 <= G) { if ((int)blockIdx.x >= first_idle) wconv_stream4(a, scr, WI_MIX_END + ((int)blockIdx.x - first_idle) * 8 + wave, WI_DENSE + WI_MOE, (G - first_idle) * 8, lane); }
    else wconv_range<false>(a, scr, WI_MIX_END + (int)blockIdx.x * 8 + wave, WI_DENSE + WI_MOE, G * 8, lane);
}
__device__ __forceinline__ void phase_outproj(const Args& a, LAS3 unsigned char* lds) {
    pg8::Gemm g{(const bf16_t*)(a.ws + WS_OPRE), (const bf16_t*)(a.ws + WS_WOUT), NTOK, DM, DM, nullptr};
    pg8::GroupedOrder S; S.init((NTOK / 256) * (DM / 256), DM / 256, 0, gridDim.x, blockIdx.x, 0);
    pg8::EpiOutproj E{a.in[0], (bf16_t*)(a.ws + WS_XNB), (const float*)(a.ws + WS_MOD), (const float*)(a.ws + WS_SS), (LAS3 float*)(lds + 131072 + 1024)};
    pg8::gemm_phase<pg8::EpiOutproj, pg8::GroupedOrder, true, true>(lds, g, S, E);
}
__device__ __forceinline__ void phase_moe1(const Args& a, LAS3 unsigned char* lds) {
    pg8::Gemm g{(const bf16_t*)(a.ws + WS_H2), (const bf16_t*)(a.ws + WS_W1), NE * 2048, NE * 3072, DM / 2, (const int*)(a.ws + WS_IDX)};
    pg8::GroupedOrder S; S.init(NE * 8 * 12, 12, 1, gridDim.x, blockIdx.x, 0);
    pg8::EpiMoe1 E{a.ws + WS_ACT};
    pg8::gemm_phase<pg8::EpiMoe1, pg8::GroupedOrder, true, true, true, true>(lds, g, S, E);
}
__device__ __forceinline__ void phase_moe2(const Args& a, LAS3 unsigned char* lds) {
    pg8::Gemm g{(const bf16_t*)(a.ws + WS_ACT), (const bf16_t*)(a.ws + WS_W2), NE * 2048, NE * DM, DE / 2, nullptr};
    pg8::GroupedOrder S; S.init(NE * 8 * 4, 4, 1, gridDim.x, blockIdx.x, 0);
    pg8::EpiMoe2 E{a.ws + WS_Y, (const float*)(a.ws + WS_GATE)};
    pg8::gemm_phase<pg8::EpiMoe2, pg8::GroupedOrder, true, true, false, true>(lds, g, S, E);
}
namespace mix {
#define MLAS __attribute__((address_space(3)))
typedef short v4i16_t __attribute__((ext_vector_type(4)));
__device__ __forceinline__ void vtr2(v4i16_t& lo, v4i16_t& hi, unsigned addr) {
    asm volatile("ds_read_b64_tr_b16 %0, %2\n\tds_read_b64_tr_b16 %1, %2 offset:2048" : "=&v"(lo), "=&v"(hi) : "v"(addr) : "memory");
}
#define VTR_WAIT(N) do { asm volatile("s_waitcnt lgkmcnt(" #N ")" ::: "memory"); __builtin_amdgcn_sched_barrier(0); } while (0)
__device__ __forceinline__ unsigned lds_addr(const MLAS unsigned char* p) { return (unsigned)(size_t)p; }
__device__ __forceinline__ float max_g4(float v) {
    const auto r1 = __builtin_amdgcn_permlane16_swap(__float_as_uint(v), __float_as_uint(v), false, false); v = fmaxf(__uint_as_float(r1[0]), __uint_as_float(r1[1]));
    const auto r2 = __builtin_amdgcn_permlane32_swap(__float_as_uint(v), __float_as_uint(v), false, false); return fmaxf(__uint_as_float(r2[0]), __uint_as_float(r2[1]));
}
__device__ __forceinline__ float sum_g4(float v) {
    const auto r1 = __builtin_amdgcn_permlane16_swap(__float_as_uint(v), __float_as_uint(v), false, false); v = __uint_as_float(r1[0]) + __uint_as_float(r1[1]);
    const auto r2 = __builtin_amdgcn_permlane32_swap(__float_as_uint(v), __float_as_uint(v), false, false); return __uint_as_float(r2[0]) + __uint_as_float(r2[1]);
}
__device__ __forceinline__ int clampi(int v, int lo, int hi) { return v < lo ? lo : (v > hi ? hi : v); }
constexpr int NSLOT = 6, SLOTB = 16384;
constexpr int BIASB = 15 * 128 * 4;
constexpr int L_RING = 0, L_BIAS = NSLOT * SLOTB, L_STAT = L_BIAS + BIASB, L_WSCR = L_STAT + 2048, WSCRB = 4352, L_ZN = 0;
static_assert(L_WSCR + 8 * WSCRB <= 147456 - 512, "mixer LDS map");
constexpr float NEG = -1e30f;
#ifndef ATT_HOST_MAX_V
#define ATT_HOST_MAX_V 18
#endif
constexpr int ATT_HOST_MAX = ATT_HOST_MAX_V;
#define ATT_WAIT_BAR(N) asm volatile("s_waitcnt vmcnt(" #N ") lgkmcnt(0)\n\ts_barrier" ::: "memory")

struct AttnStream {
    int u0, nu, iu, it, us;
    int nrows; const bf16_t* rp;
};
__device__ __forceinline__ void unit_geom(int unit, int& b, int& h, int& r0, int& U0, int& nrows) {
    b = unit >> 7; h = (unit >> 4) & 7; r0 = (unit & 15) * 2; U0 = clampi(r0 - 4, 0, ROWS - 8); const int nwin = clampi(r0 - 3, 0, ROWS - 8) + 8 - U0; nrows = (nwin + 1) & ~1;
}
__device__ __forceinline__ void attn_seek(const Args& a, AttnStream& S, int wid, int lane) {
    const bf16_t* Z = (const bf16_t*)(a.ws + WS_Z); const bf16_t* KVC = (const bf16_t*)(a.ws + WS_KVC);
    int b, h, r0, U0, nrows; unit_geom(S.u0 + S.iu * S.us, b, h, r0, U0, nrows); S.nrows = nrows;
    const int row = 8 * wid + (lane >> 3);
    S.rp = (S.it < nrows) ? Z + (size_t)(b * SEQ + (U0 + S.it) * GW + row) * DIN + DNA + h * HD
                          : KVC + (size_t)(b * CTXL + (S.it - nrows) * 64 + row) * DM + h * HD;
}
__device__ __forceinline__ void attn_issue(const Args& a, MLAS unsigned char* lds, AttnStream& S, int slot, int wid, int lane) {
    const int ck = (lane & 7) ^ (lane >> 3);
    const int cv = ((((lane & 7) >> 1) ^ ((lane >> 4) & 3)) << 1) | (lane & 1);
    MLAS unsigned char* dst = lds + L_RING + slot * SLOTB + wid * 1024;
    __builtin_amdgcn_global_load_lds((const unsigned*)(S.rp + ck * 8), (MLAS unsigned*)dst, 16, 0, 0);
    __builtin_amdgcn_global_load_lds((const unsigned*)(S.rp + 512 + cv * 8), (MLAS unsigned*)(dst + 8192), 16, 0, 0);
    const int it1 = S.it + 1;
    if (it1 < S.nrows) { S.it = it1; S.rp += (size_t)GW * DIN; }
    else if (it1 > S.nrows && it1 < S.nrows + CTXL / 64) { S.it = it1; S.rp += (size_t)64 * DM; }
    else if (it1 == S.nrows) { S.it = it1; attn_seek(a, S, wid, lane); }
    else if (S.iu + 1 < S.nu) { ++S.iu; S.it = 0; attn_seek(a, S, wid, lane); }
}

template <bool WIN>
__device__ __forceinline__ void attn_step(const MLAS unsigned char* Kp0, const MLAS unsigned char* Kp1, bool use0, bool use1, const MLAS float* brow0, const MLAS float* brow1,
                                          const f32x4 (&negmask)[2], const bf16x8 qf0, const bf16x8 qf1, float& mrun, float& lrun, f32x4 (&O)[4], int koff0, int koff1, int voff, int vsw) {
    const unsigned va0 = lds_addr(Kp0 + 8192) + voff, va1 = lds_addr(Kp1 + 8192) + voff;
    v4i16_t x0[4], y0[4], x1[4], y1[4];
    if (use0) {
#pragma unroll
        for (int db = 0; db < 4; ++db) vtr2(x0[db], y0[db], va0 + ((db ^ vsw) << 5)); }
    if (use1) {
#pragma unroll
        for (int db = 0; db < 4; ++db) vtr2(x1[db], y1[db], va1 + ((db ^ vsw) << 5)); }
    f32x4 s[4];
#pragma unroll
    for (int pr = 0; pr < 2; ++pr) {
        const bool use = pr ? use1 : use0; const MLAS unsigned char* Kp = pr ? Kp1 : Kp0;
        if (use) {
#pragma unroll
            for (int kbi = 0; kbi < 2; ++kbi) {
                const bf16x8 a0 = *(const MLAS bf16x8*)(Kp + kbi * 2048 + koff0), a1 = *(const MLAS bf16x8*)(Kp + kbi * 2048 + koff1);
                const f32x4 c0 = WIN ? negmask[kbi] : (f32x4){0.f, 0.f, 0.f, 0.f};
                const f32x4 acc = __builtin_amdgcn_mfma_f32_16x16x32_bf16(a0, qf0, c0, 0, 0, 0);
                s[2 * pr + kbi] = __builtin_amdgcn_mfma_f32_16x16x32_bf16(a1, qf1, acc, 0, 0, 0);
            }
        } else { s[2 * pr] = (f32x4){NEG, NEG, NEG, NEG}; s[2 * pr + 1] = (f32x4){NEG, NEG, NEG, NEG}; }
    }
    if (WIN) {
        f32x4 bv[4];
#pragma unroll
        for (int pr = 0; pr < 2; ++pr) { const MLAS float* br = pr ? brow1 : brow0;
#pragma unroll
            for (int kbi = 0; kbi < 2; ++kbi)
#pragma unroll
                for (int j = 0; j < 4; ++j) bv[2 * pr + kbi][j] = br[kbi * 16 + j]; }
        asm volatile("" : "+v"(bv[0]), "+v"(bv[1]), "+v"(bv[2]), "+v"(bv[3]));
#pragma unroll
        for (int k = 0; k < 4; ++k) s[k] = s[k] + bv[k];
    }
    float mt = fmaxf(fmaxf(s[0][0], s[0][1]), fmaxf(s[0][2], s[0][3]));
#pragma unroll
    for (int k = 1; k < 4; ++k) mt = fmaxf(fmaxf(mt, fmaxf(s[k][0], s[k][1])), fmaxf(s[k][2], s[k][3]));
    mt = max_g4(mt);
    if (__any(mt > mrun + 8.f)) {
        const float mn = fmaxf(mrun, mt), alpha = __builtin_amdgcn_exp2f(mrun - mn); mrun = mn; lrun *= alpha;
#pragma unroll
        for (int db = 0; db < 4; ++db) O[db] = O[db] * alpha;
    }
#pragma unroll
    for (int k = 0; k < 4; ++k)
#pragma unroll
        for (int j = 0; j < 4; ++j) s[k][j] = __builtin_amdgcn_exp2f(s[k][j] - mrun);
    { const f32x4 t4 = (s[0] + s[1]) + (s[2] + s[3]); lrun += (t4[0] + t4[1]) + (t4[2] + t4[3]); }
    {
        u32x4 pw0, pw1;
        pw0.x = cvtpk(s[0][0], s[0][1]); pw0.y = cvtpk(s[0][2], s[0][3]); pw0.z = cvtpk(s[1][0], s[1][1]); pw0.w = cvtpk(s[1][2], s[1][3]);
        pw1.x = cvtpk(s[2][0], s[2][1]); pw1.y = cvtpk(s[2][2], s[2][3]); pw1.z = cvtpk(s[3][0], s[3][1]); pw1.w = cvtpk(s[3][2], s[3][3]);
        const bf16x8 pf0 = __builtin_bit_cast(bf16x8, pw0), pf1 = __builtin_bit_cast(bf16x8, pw1);
        if (use0) {
            VTR_WAIT(0);
#pragma unroll
            for (int db = 0; db < 4; ++db) { const bf16x8 af = (bf16x8){x0[db][0], x0[db][1], x0[db][2], x0[db][3], y0[db][0], y0[db][1], y0[db][2], y0[db][3]};
                O[db] = __builtin_amdgcn_mfma_f32_16x16x32_bf16(af, pf0, O[db], 0, 0, 0); }
        }
        if (use1) {
            VTR_WAIT(0);
#pragma unroll
            for (int db = 0; db < 4; ++db) { const bf16x8 af = (bf16x8){x1[db][0], x1[db][1], x1[db][2], x1[db][3], y1[db][0], y1[db][1], y1[db][2], y1[db][3]};
                O[db] = __builtin_amdgcn_mfma_f32_16x16x32_bf16(af, pf1, O[db], 0, 0, 0); }
        }
    }
}

__device__ __forceinline__ void attn_units(const Args& a, MLAS unsigned char* lds, int u0, int nu, int us, int& wit, bool accum) {
    const int tid = threadIdx.x, lane = tid & 63, wid = __builtin_amdgcn_readfirstlane(tid >> 6);
    const int q = lane & 15, g = lane >> 4;
    const bf16_t* Z = (const bf16_t*)(a.ws + WS_Z); bf16_t* OP = (bf16_t*)(a.ws + WS_OPRE);
    AttnStream S; S.u0 = u0; S.nu = nu; S.iu = 0; S.it = 0; S.us = us; attn_seek(a, S, wid, lane);
    int islot = 0, cslot = 0;
#pragma unroll
    for (int d = 0; d < NSLOT; ++d) { attn_issue(a, lds, S, islot, wid, lane); islot = (islot + 1 == NSLOT) ? 0 : islot + 1; }
    MLAS float* biasl = (MLAS float*)(lds + L_BIAS);
    const int koff0 = q * 128 + ((g ^ (q & 7)) << 4), koff1 = q * 128 + (((4 + g) ^ (q & 7)) << 4);
    const int q4 = q >> 2, p4 = q & 3, vrow = 4 * g + q4;
    const int vsw = (vrow >> 1) & 3, voff = vrow * 128 + (p4 & 1) * 8 + ((p4 >> 1) << 4);
    const int qg = wid & 3, qc = 16 * qg + q, cs = clampi(qc - 8, 0, GW - 16);
    const int kcs = (qg == 0) ? 0 : ((qg == 1) ? 8 : ((qg == 2) ? 24 : 32));
    f32x4 negmask[2];
#pragma unroll
    for (int kbi = 0; kbi < 2; ++kbi)
#pragma unroll
        for (int j = 0; j < 4; ++j) { const int kc = kcs + 16 * kbi + 4 * g + j; negmask[kbi][j] = (kc >= cs && kc < cs + 16) ? 0.f : NEG; }
    const int bidx0 = kcs + 4 * g - qc + 63;
    int hprev = -1, prev_n = 0;
    f32x4 wr_[8]; unsigned char* wop_ = nullptr; bool wfly = false; int wage = 0, whosted = 0, wstep = 0;
    const unsigned wscr = lds_addr(lds + L_WSCR + wid * WSCRB);
    const int wstride = (int)gridDim.x * 8, wlast = WI_MIX_END;
    int b, h, r0, U0, nrows; unit_geom(u0, b, h, r0, U0, nrows);
    bf16x8 qn0, qn1;
    { const bf16_t* qp = Z + (size_t)(b * SEQ + (r0 + (wid >> 2)) * GW + qc) * DIN + h * HD + 8 * g; qn0 = *(const bf16x8*)qp; qn1 = *(const bf16x8*)(qp + 32); }
    for (int iu = 0; iu < nu; ++iu) {
        unit_geom(u0 + iu * us, b, h, r0, U0, nrows);
        const int qrow = r0 + (wid >> 2), rsq = clampi(qrow - 4, 0, ROWS - 8);
        if (h != hprev) {
            if (hprev >= 0) ATT_WAIT_BAR(0);
            for (int i = tid; i < 15 * 128; i += 512) { const int rr = i >> 7, d = (i & 127) - 48; biasl[i] = (d >= 0 && d < 31) ? LOG2E * a.in[8][(h * 15 + rr) * 31 + d] : 0.f; }
            hprev = h;
        }
        const bf16x8 qf0 = qn0, qf1 = qn1;
        if (iu + 1 < nu) { int b2, h2, r2, U2, n2; unit_geom(u0 + (iu + 1) * us, b2, h2, r2, U2, n2);
            const bf16_t* qp = Z + (size_t)(b2 * SEQ + (r2 + (wid >> 2)) * GW + qc) * DIN + h2 * HD + 8 * g; qn0 = *(const bf16x8*)qp; qn1 = *(const bf16x8*)(qp + 32); }
        float mrun = NEG, lrun = 0.f;
        f32x4 O[4];
#pragma unroll
        for (int db = 0; db < 4; ++db) O[db] = (f32x4){0.f, 0.f, 0.f, 0.f};
        const int nsw = nrows >> 1, nst = nsw + CTXL / 64;
        for (int st = 0; st < nst; ++st) {
            if (wfly) { ATT_WAIT_BAR(12); ++wage; } else { ATT_WAIT_BAR(4); }
            if (wfly && wage == 2) { titem8_store(wop_, wr_, wscr, lane); wfly = false; }
            for (int k = 0; k < prev_n; ++k) { attn_issue(a, lds, S, islot, wid, lane); islot = (islot + 1 == NSLOT) ? 0 : islot + 1; }
            ++wstep;
            if (!wfly && wit < wlast && whosted < ATT_HOST_MAX && (wstep > 1 || (wid & 1) == 0)) { const TItem I = wconv_item(a, wit); titem8_load(I, wr_, lane); wop_ = titem8_outptr(I, lane); wit += wstride; wfly = true; wage = 0; ++whosted; }
            const MLAS unsigned char* sl0 = lds + L_RING + cslot * SLOTB;
            if (st < nsw) {
                const int c1 = (cslot + 1 == NSLOT) ? 0 : cslot + 1; const MLAS unsigned char* sl1 = lds + L_RING + c1 * SLOTB;
                const int krA = U0 + 2 * st, krB = krA + 1;
                const bool uA = (krA >= rsq) && (krA < rsq + 8), uB = (krB >= rsq) && (krB < rsq + 8);
                if (uA || uB)
                    attn_step<true>(sl0 + kcs * 128, sl1 + kcs * 128, uA, uB, biasl + clampi(krA - qrow + 7, 0, 14) * 128 + bidx0, biasl + clampi(krB - qrow + 7, 0, 14) * 128 + bidx0, negmask, qf0, qf1, mrun, lrun, O, koff0, koff1, voff, vsw);
                cslot = (c1 + 1 == NSLOT) ? 0 : c1 + 1; prev_n = 2;
            } else {
                attn_step<false>(sl0, sl0 + 32 * 128, true, true, biasl, biasl, negmask, qf0, qf1, mrun, lrun, O, koff0, koff1, voff, vsw);
                cslot = (cslot + 1 == NSLOT) ? 0 : cslot + 1; prev_n = 1;
            }
        }
        const float l = sum_g4(lrun);
        const float inv = 1.f / l;
        bf16_t* op = OP + (size_t)(b * SEQ + qrow * GW + qc) * DM + h * HD + 4 * g;
        float ssq = 0.f;
#pragma unroll
        for (int db = 0; db < 4; ++db) { const f32x4 o = O[db] * inv; u32x2 w; w.x = cvtpk(o[0], o[1]); w.y = cvtpk(o[2], o[3]); *(u32x2*)(op + db * 16) = w; ssq += (o[0] * o[0] + o[1] * o[1]) + (o[2] * o[2] + o[3] * o[3]); }
        ssq = sum_g4(ssq);
        if (g == 0 && accum) atomicAdd((float*)(a.ws + WS_SS) + (size_t)(b * SEQ + qrow * GW + qc) * 2, ssq);
    }
    if (wfly) titem8_store(wop_, wr_, wscr, lane);
    ATT_WAIT_BAR(0);
}

__device__ __forceinline__ void gmlp_unit(const Args& a, MLAS unsigned char* lds, int unit, bool accum, int& wit) {
    const int tid = threadIdx.x, lane = tid & 63, wid = __builtin_amdgcn_readfirstlane(tid >> 6);
    const int q = lane & 15, g = lane >> 4;
    const bf16_t* Z = (const bf16_t*)(a.ws + WS_Z); bf16_t* OP = (bf16_t*)(a.ws + WS_OPRE);
    const int half = unit & 1, c = (unit >> 1) & 15, b = unit >> 5;
    const int row0 = b * SEQ + c * 128;
    MLAS float* st = (MLAS float*)(lds + L_STAT);
    const int srow = tid >> 3, sch = tid & 7;
    const int prow = row0 + wid * 16 + q;
    u32x4 zs[16], zt[4][2];
#pragma unroll
    for (int rr = 0; rr < 16; ++rr) zs[rr] = *((const u32x4*)(Z + (size_t)(row0 + wid * 16 + rr) * DIN + 2048) + lane);
    bf16x8 bfr[4][4]; f32x4 gn[4][2]; u32x2 uw[4][4]; float bsv[4];
#define GMLP_LOAD_EARLY(gi_) do { const int ch0_ = (half * 4 + (gi_)) * 64; \
        gn[gi_][0] = *(const f32x4*)(a.in[11] + ch0_ + sch * 8); gn[gi_][1] = *(const f32x4*)(a.in[11] + ch0_ + sch * 8 + 4); \
        _Pragma("unroll") for (int hh = 0; hh < 2; ++hh) zt[gi_][hh] = *(const u32x4*)(Z + (size_t)(row0 + srow + 64 * hh) * DIN + 2048 + ch0_ + sch * 8); } while (0)
#define GMLP_LOAD_LATE(gi_) do { const int g8_ = half * 4 + (gi_), ch0_ = g8_ * 64; \
        const float* wrow_ = a.in[9] + (size_t)(g8_ * 128 + wid * 16 + q) * 128 + 4 * g; \
        _Pragma("unroll") for (int ks = 0; ks < 4; ++ks) { const f32x4 w0 = *(const f32x4*)(wrow_ + ks * 32), w1 = *(const f32x4*)(wrow_ + ks * 32 + 16); \
            u32x4 pw; pw.x = cvtpk(w0[0], w0[1]); pw.y = cvtpk(w0[2], w0[3]); pw.z = cvtpk(w1[0], w1[1]); pw.w = cvtpk(w1[2], w1[3]); bfr[gi_][ks] = __builtin_bit_cast(bf16x8, pw); } \
        _Pragma("unroll") for (int db = 0; db < 4; ++db) uw[gi_][db] = *(const u32x2*)(Z + (size_t)prow * DIN + 1536 + ch0_ + db * 16 + 4 * g); \
        bsv[gi_] = a.in[10][g8_ * 128 + wid * 16 + q]; } while (0)
    GMLP_LOAD_EARLY(0);
#pragma unroll
    for (int rr = 0; rr < 16; ++rr) {
        const u32x4 w = zs[rr];
        const float v[8] = {bflo(w.x), bfhi(w.x), bflo(w.y), bfhi(w.y), bflo(w.z), bfhi(w.z), bflo(w.w), bfhi(w.w)};
        float s = 0.f, s2 = 0.f;
#pragma unroll
        for (int i = 0; i < 8; ++i) { s += v[i]; s2 += v[i] * v[i]; }
#pragma unroll
        for (int o = 1; o < 64; o <<= 1) { s += __shfl_xor(s, o); s2 += __shfl_xor(s2, o); }
        const float mean = s * (1.f / DSG), var = fmaxf(s2 * (1.f / DSG) - mean * mean, 0.f);
        if (lane == 0) { st[(wid * 16 + rr) * 2] = mean; st[(wid * 16 + rr) * 2 + 1] = rsqrtf(var + EPS); }
    }
    LDS_BARRIER();
    const int q4 = q >> 2, p4 = q & 3;
    const int vrow = 4 * g + q4, vsw = (vrow >> 1) & 3, voff = vrow * 128 + (p4 & 1) * 8 + ((p4 >> 1) << 4);
    float ssq = 0.f;
#pragma unroll
    for (int gi = 0; gi < 4; ++gi) {
        const int g8 = half * 4 + gi, ch0 = g8 * 64;
        MLAS unsigned char* zb = lds + L_ZN + (gi & 1) * 16384;
        f32x4 wr_[8]; const int wmine = wit; const bool whave = accum && (wit < WI_MIX_END);
        unsigned char* wop_ = nullptr;
        if (whave) { const TItem I = wconv_item(a, wmine); titem8_load(I, wr_, lane); wop_ = titem8_outptr(I, lane); wit += (int)gridDim.x * 8; }
        GMLP_LOAD_LATE(gi);
        if (gi + 1 < 4) GMLP_LOAD_EARLY(gi + 1);
#pragma unroll
        for (int hh = 0; hh < 2; ++hh) {
            const int r = srow + 64 * hh;
            const u32x4 w = zt[gi][hh];
            const float mean = st[r * 2], rstd = st[r * 2 + 1];
            const f32x4 gn0 = gn[gi][0] * rstd, gn1 = gn[gi][1] * rstd;
            u32x4 o;
            o.x = cvtpk((bflo(w.x) - mean) * gn0[0], (bfhi(w.x) - mean) * gn0[1]); o.y = cvtpk((bflo(w.y) - mean) * gn0[2], (bfhi(w.y) - mean) * gn0[3]);
            o.z = cvtpk((bflo(w.z) - mean) * gn1[0], (bfhi(w.z) - mean) * gn1[1]); o.w = cvtpk((bflo(w.w) - mean) * gn1[2], (bfhi(w.w) - mean) * gn1[3]);
            *(MLAS u32x4*)(zb + r * 128 + (((((sch >> 1) ^ ((r >> 1) & 3)) << 1) | (sch & 1)) << 4)) = o;
        }
        LDS_BARRIER();
        f32x4 D[4];
#pragma unroll
        for (int db = 0; db < 4; ++db) D[db] = (f32x4){0.f, 0.f, 0.f, 0.f};
        const unsigned zba = lds_addr(zb) + voff;
#pragma unroll
        for (int kh = 0; kh < 2; ++kh) {
            v4i16_t x0[2][4], y0[2][4];
#pragma unroll
            for (int k2 = 0; k2 < 2; ++k2)
#pragma unroll
                for (int db = 0; db < 4; ++db) vtr2(x0[k2][db], y0[k2][db], zba + (2 * kh + k2) * 4096 + ((db ^ vsw) << 5));
#pragma unroll
            for (int k2 = 0; k2 < 2; ++k2) {
                if (k2 == 0) VTR_WAIT(8); else VTR_WAIT(0);
#pragma unroll
                for (int db = 0; db < 4; ++db) { const bf16x8 af = (bf16x8){x0[k2][db][0], x0[k2][db][1], x0[k2][db][2], x0[k2][db][3], y0[k2][db][0], y0[k2][db][1], y0[k2][db][2], y0[k2][db][3]};
                    D[db] = __builtin_amdgcn_mfma_f32_16x16x32_bf16(af, bfr[gi][2 * kh + k2], D[db], 0, 0, 0); }
            }
        }
#pragma unroll
        for (int db = 0; db < 4; ++db) {
            const float o0 = bflo(uw[gi][db].x) * (D[db][0] + bsv[gi]), o1 = bfhi(uw[gi][db].x) * (D[db][1] + bsv[gi]), o2 = bflo(uw[gi][db].y) * (D[db][2] + bsv[gi]), o3 = bfhi(uw[gi][db].y) * (D[db][3] + bsv[gi]);
            u32x2 w; w.x = cvtpk(o0, o1); w.y = cvtpk(o2, o3); ssq += (o0 * o0 + o1 * o1) + (o2 * o2 + o3 * o3);
            *(u32x2*)(OP + (size_t)prow * DM + DNA + ch0 + db * 16 + 4 * g) = w;
        }
        if (whave) titem8_store(wop_, wr_, lds_addr(lds + L_WSCR + wid * WSCRB), lane);
    }
    ssq += __shfl_xor(ssq, 16); ssq += __shfl_xor(ssq, 32);
    if (g == 0 && accum) atomicAdd((float*)(a.ws + WS_SS) + (size_t)prow * 2 + 1, ssq);
    LDS_BARRIER();
#undef GMLP_LOAD_EARLY
#undef GMLP_LOAD_LATE
}

__device__ __forceinline__ void phase_mix(const Args& a, MLAS unsigned char* lds) {
    const int G = gridDim.x; const int vcu = (G % 8 == 0) ? ((int)blockIdx.x % 8) * (G / 8) + (int)blockIdx.x / 8 : (int)blockIdx.x;
    constexpr int NAU = NB * NH * (ROWS / 2), NGU = NB * (SEQ / 128) * 2;
    const int upc = (NAU + G - 1) / G;
    const int wave = __builtin_amdgcn_readfirstlane(threadIdx.x >> 6), lane = threadIdx.x & 63;
    int wit = WI_DENSE + (int)blockIdx.x * 8 + wave;
    if (upc == 4 && NAU == 4 * G) {
        const int u0 = (vcu >> 2) * 16 + (vcu & 3); attn_units(a, lds, u0, 4, 4, wit, true); if (REP_MASK_V & 0x10000u) attn_units(a, lds, u0, 4, 4, wit, false);
    } else { const int u0 = vcu * upc, nu = (u0 + upc <= NAU) ? upc : (NAU - u0); if (nu > 0) { attn_units(a, lds, u0, nu, 1, wit, true); if (REP_MASK_V & 0x10000u) attn_units(a, lds, u0, nu, 1, wit, false); } }
    for (int unit = vcu; unit < NGU; unit += G) { gmlp_unit(a, lds, unit, true, wit); if (REP_MASK_V & 0x20000u) gmlp_unit(a, lds, unit, false, wit); }
    wconv_range<false>(a, lds_addr(lds + L_WSCR + wave * WSCRB), wit, WI_MIX_END, G * 8, lane);
}
}
#define GAS __attribute__((address_space(1)))
#define LAS __attribute__((address_space(3)))
constexpr int NWAVES = 8;
constexpr int RING_BYTES = 131072;
constexpr int LDSCTL_OFF = 147456 - 512, MISC_OFF = LDSCTL_OFF + 320;
constexpr int LDS_BYTES = 147456;
constexpr size_t CTL_ZERO_BYTES = 1 * MiB;
constexpr int CW_BAR = 4096;

#define XB_TMO      128
#define XB_XCNT(j)  (256  + 64 * (j))
#define XB_XSUB(j)  (1280 + 64 * (j))
#define XB_XGEN(j)  (2304 + 64 * (j))
#define XB_TOP      3328
#define XB_TOPGEN   3392
#define XCD_BAR_WORDS 3456
#define XB_SPIN_CAP (1u << 18)

__device__ __forceinline__ unsigned xb_ld(unsigned* p)              { return __hip_atomic_load(p, __ATOMIC_RELAXED, __HIP_MEMORY_SCOPE_AGENT); }
__device__ __forceinline__ unsigned xb_add(unsigned* p, unsigned v) { return __hip_atomic_fetch_add(p, v, __ATOMIC_RELAXED, __HIP_MEMORY_SCOPE_AGENT); }
__device__ __forceinline__ unsigned xb_xcc_id() { return (unsigned)__builtin_amdgcn_s_getreg((3 << 11) | 20) & 0xFu; }
#define XB_SPIN(cond, bar) do { unsigned _sp = 0; while (cond) { __builtin_amdgcn_s_sleep(1); \
    if ((++_sp & 255u) == 0u) { if (xb_ld(&(bar)[XB_TMO])) break; if (_sp > XB_SPIN_CAP) { atomicAdd(&(bar)[XB_TMO], 1u); break; } } } } while (0)

struct XcdBarrier { unsigned* bar; unsigned x; volatile LAS unsigned* st; };

__device__ __forceinline__ XcdBarrier xcd_barrier_post(unsigned* bar, volatile LAS unsigned* st) {
    XcdBarrier b; b.bar = bar; b.x = xb_xcc_id(); b.st = st;
    if (threadIdx.x == 0) (void)xb_add(&bar[XB_XCNT(b.x)], 1u);
    return b;
}
__device__ __forceinline__ void xcd_barrier_complete(unsigned* bar, unsigned x, unsigned& nloc, unsigned& nx) {
    const unsigned G = gridDim.x * gridDim.y * gridDim.z;
    unsigned sum, cnt, mine, sp = 0u;
    for (;;) {
        sum = 0u; cnt = 0u; mine = 0u;
#pragma unroll
        for (unsigned j = 0; j < 16; ++j) { const unsigned c = xb_ld(&bar[XB_XCNT(j)]); sum += c; cnt += (c > 0u) ? 1u : 0u; mine = (j == x) ? c : mine; }
        if (sum == G) break;
        __builtin_amdgcn_s_sleep(1);
        if ((++sp & 255u) == 0u) { if (xb_ld(&bar[XB_TMO])) break; if (sp > XB_SPIN_CAP) { atomicAdd(&bar[XB_TMO], 1u); break; } }
    }
    nloc = mine > 0u ? mine : 1u; nx = cnt > 0u ? cnt : 1u;
}
__device__ __forceinline__ void xcd_barrier(const XcdBarrier& b) {
    asm volatile("s_waitcnt vmcnt(0)" ::: "memory");
    __syncthreads();
    if (threadIdx.x == 0) {
        unsigned* bar = b.bar;
        __builtin_amdgcn_s_waitcnt(0);
        unsigned nloc = b.st[0], nx = b.st[1];
        if (nloc == 0u) { xcd_barrier_complete(bar, b.x, nloc, nx); b.st[0] = nloc; b.st[1] = nx; }
        const unsigned old = xb_add(&bar[XB_XSUB(b.x)], 1u);
        const unsigned gen = old / nloc;
        if (old + 1u == (gen + 1u) * nloc) {
            __builtin_amdgcn_fence(__ATOMIC_RELEASE, "agent");
            asm volatile("s_waitcnt vmcnt(0)" ::: "memory");
            (void)xb_add(&bar[XB_TOP], 1u);
        }
        XB_SPIN(xb_ld(&bar[XB_TOP]) < (gen + 1u) * nx, bar);
        __builtin_amdgcn_fence(__ATOMIC_ACQUIRE, "agent");
        asm volatile("s_waitcnt vmcnt(0)" ::: "memory");
    }
    __syncthreads();
}

constexpr int NPHASE = 10;
constexpr unsigned REP_MASK = REP_MASK_V;
__global__ void __launch_bounds__(NWAVES * 64, 2) mk_fwd(Args a) {
    extern __shared__ __attribute__((aligned(16))) unsigned char lds_raw[];
    float* lds = (float*)lds_raw;
    LAS unsigned char* ldsl = (LAS unsigned char*)lds_raw;
    for (int u = threadIdx.x; u < 512 / 4; u += NWAVES * 64) ((LAS unsigned*)(ldsl + LDSCTL_OFF))[u] = 0u;
    __syncthreads();
    unsigned* ctl = (unsigned*)(a.ws + WS_CTL);
    XcdBarrier bar = xcd_barrier_post(ctl + CW_BAR, (volatile LAS unsigned*)(ldsl + MISC_OFF) + 8);
    const int lo = a.ph_lo, hi = a.ph_hi;
#define IN(k) (lo <= (k) && (k) < hi)
#define SEAM(k) do { if (IN(k) && IN((k) + 1)) xcd_barrier(bar); } while (0)
#define REP(k, body) do { if (IN(k)) { body; if ((REP_MASK >> (k)) & 1u) { xcd_barrier(bar); body; } } } while (0)
    REP(0, { phase_mod(a, lds); phase_wconv(a, lds); }); if (IN(0) && IN(1)) mod_pre_wait(a);
    REP(1, { phase_prenorm(a); }); SEAM(1);
    REP(2, { phase_inproj(a, ldsl); }); SEAM(2);
    REP(3, { mix::phase_mix(a, ldsl); }); SEAM(3);
    REP(4, { phase_outproj(a, ldsl); }); SEAM(4);
    if (gridDim.x == NTOK / 64) { if (IN(5)) phase_norm2_topk(a, lds); SEAM(5); }
    else { REP(5, { phase_norm2(a, lds); }); SEAM(5); REP(6, { phase_topk(a, lds); }); if (IN(6)) xcd_barrier(bar); }
    REP(7, { phase_moe1(a, ldsl); }); SEAM(7);
    REP(8, { phase_moe2(a, ldsl); }); SEAM(8);
    if (IN(9)) { if (REP_MASK & 0x200u) { phase_final(a, (float*)(a.ws + WS_ACT)); xcd_barrier(bar); } phase_final(a, a.out); }
#undef REP
#undef IN
#undef SEAM
}

extern "C" void kernel_launch(void* const* d_in, const int* in_sizes, int n_in, void* d_out, int out_size, void* d_ws, size_t ws_size, hipStream_t stream) {
    static int grid = 0;
    if (grid == 0) {
        if (n_in != 21 || out_size != NTOK * DM || ws_size < WS_END) { fprintf(stderr, "kernel_launch: unexpected shapes n_in %d out %d ws %zu\n", n_in, out_size, ws_size); grid = -1; return; }
        int dev = 0, cus = 0, per_cu = 0;
        if (hipGetDevice(&dev) != hipSuccess || hipDeviceGetAttribute(&cus, hipDeviceAttributeMultiprocessorCount, dev) != hipSuccess) { grid = -1; return; }
        if (hipFuncSetAttribute((const void*)mk_fwd, hipFuncAttributeMaxDynamicSharedMemorySize, LDS_BYTES) != hipSuccess) { fprintf(stderr, "kernel_launch: hipFuncSetAttribute failed\n"); grid = -1; return; }
        if (hipOccupancyMaxActiveBlocksPerMultiprocessor(&per_cu, (const void*)mk_fwd, NWAVES * 64, LDS_BYTES) != hipSuccess || per_cu < 1)
            fprintf(stderr, "kernel_launch: note: occupancy query reports %d workgroups per CU\n", per_cu);
        (void)hipGetLastError();
        grid = cus;
    }
    if (grid < 0) return;
    if (hipMemsetAsync((char*)d_ws + WS_CTL, 0, CTL_ZERO_BYTES, stream) != hipSuccess) return;
    Args a{};
    for (int i = 0; i < 21; ++i) a.in[i] = (const float*)d_in[i];
    a.out = (float*)d_out; a.ws = (unsigned char*)d_ws; a.ph_lo = 0; a.ph_hi = NPHASE;
    hipLaunchKernelGGL(mk_fwd, dim3(grid), dim3(NWAVES * 64), LDS_BYTES, stream, a);
}
```

```cpp
#include <hip/hip_runtime.h>
#include <cstdio>
#include <cstdint>
#ifndef REP_MASK_V
#define REP_MASK_V 0u
#endif

typedef unsigned short bf16_t;
typedef short bf16x8 __attribute__((ext_vector_type(8)));
typedef float f32x4 __attribute__((ext_vector_type(4)));
typedef float f32x2 __attribute__((ext_vector_type(2)));
typedef unsigned u32x4 __attribute__((ext_vector_type(4)));
typedef unsigned u32x2 __attribute__((ext_vector_type(2)));
typedef __bf16 bf16x2_t __attribute__((ext_vector_type(2)));

constexpr int NB = 8, SEQ = 2048, DM = 1024, NTOK = NB * SEQ, CTXL = 256, NCTX = NB * CTXL;
constexpr int GW = 64, ROWS = SEQ / GW;
constexpr int NH = 8, HD = 64, DNA = 512, DSG = 512, DIN = 2560;
constexpr int NE = 16, CAP = 256, DE = 1536, NMOD = 6 * DM;
constexpr float EPS = 1e-6f;
constexpr float LOG2E = 1.4426950408889634f;
constexpr float Y8_SCALE = 64.f;
constexpr float W8_SCALE = 128.f, A8_SCALE = 4.f;
constexpr float QSCALE = 0.125f * LOG2E;

constexpr size_t MiB = 1u << 20;
constexpr size_t WS_CTL = 0;
constexpr size_t WS_PCNT = 128 * 1024;
constexpr size_t WS_SS = 256 * 1024;
constexpr size_t WS_MOD = 1 * MiB;
constexpr size_t WS_AFF = 2 * MiB;
constexpr size_t WS_GATE = 3 * MiB;
constexpr size_t WS_IDX = 3 * MiB + 512 * 1024;
constexpr size_t WS_SEL = 4 * MiB;
constexpr size_t WS_WOUT = 5 * MiB;
constexpr size_t WS_WIN = 7 * MiB;
constexpr size_t WS_W2 = 12 * MiB;
constexpr size_t WS_W1 = 60 * MiB;
constexpr size_t WS_XNB = 108 * MiB;
constexpr size_t WS_ACT = 156 * MiB;
constexpr size_t WS_Z = 156 * MiB;
constexpr size_t WS_H2 = 252 * MiB;
constexpr size_t WS_Y = 252 * MiB;
constexpr size_t WS_H = 252 * MiB;
constexpr size_t WS_KVC = 288 * MiB;
constexpr size_t WS_OPRE = 252 * MiB;
constexpr size_t WS_END = 316 * MiB;

struct Args { const float* in[21]; float* out; unsigned char* ws; int ph_lo, ph_hi; };

__device__ __forceinline__ unsigned cvtpk(float lo, float hi) { f32x2 v = {lo, hi}; bf16x2_t b = __builtin_convertvector(v, bf16x2_t); return __builtin_bit_cast(unsigned, b); }
__device__ __forceinline__ bf16_t f2bf(float f) { return (bf16_t)(cvtpk(f, 0.f) & 0xffffu); }
__device__ __forceinline__ float bf2f(bf16_t b) { return __uint_as_float(((unsigned)b) << 16); }
__device__ __forceinline__ float bflo(unsigned w) { return __uint_as_float(w << 16); }
__device__ __forceinline__ float bfhi(unsigned w) { return __uint_as_float(w & 0xffff0000u); }
__device__ __forceinline__ float clamp8(float v) { return __builtin_fminf(__builtin_fmaxf(v, -448.f), 448.f); }
__device__ __forceinline__ unsigned cvt4_fp8(float a, float b, float c, float d) {
    int w = __builtin_amdgcn_cvt_pk_fp8_f32(clamp8(a), clamp8(b), 0, false); w = __builtin_amdgcn_cvt_pk_fp8_f32(clamp8(c), clamp8(d), w, true); return (unsigned)w;
}
#define LDS_BARRIER() asm volatile("s_waitcnt lgkmcnt(0)\n\ts_barrier" ::: "memory")
__device__ __forceinline__ float wave_sum(float v) {
#pragma unroll
    for (int o = 1; o < 64; o <<= 1) v += __shfl_xor(v, o);
    return v;
}
__device__ __forceinline__ float wave_max(float v) {
#pragma unroll
    for (int o = 1; o < 64; o <<= 1) v = fmaxf(v, __shfl_xor(v, o));
    return v;
}
__device__ __forceinline__ float silu_f(float x) { return x / (1.f + __expf(-x)); }
__device__ __forceinline__ float gelu_tanh(float x) {
    const float u = 1.5957691216057308f * (x + 0.044715f * x * x * x);
    return x / (1.f + __expf(-u));
}

constexpr int MOD_PRE_ITEMS = 2 * DM / 32;
__device__ __forceinline__ void phase_mod(const Args& a, float* lds) {
    const float* c = a.in[1]; const float* cc = a.in[3]; const float* wm = a.in[4]; const float* bm = a.in[5];
    float* MOD = (float*)(a.ws + WS_MOD);
    float* s = lds;
    float* red = lds + 1024 * 12;
    const int t = threadIdx.x;
    const int item0 = blockIdx.x; const bool has = item0 < NMOD / 32;
    const int col = item0 * 32 + (t & 31), kg = t >> 5;
    float w[64];
    if (has) { const float* wp = wm + (size_t)(kg * 64) * NMOD + col;
#pragma unroll
        for (int k = 0; k < 64; ++k) w[k] = __builtin_nontemporal_load(wp + (size_t)k * NMOD); }
    for (int i = t; i < 9 * 1024; i += 512) { const int r = i >> 10, k = i & 1023; const float v = (r < 8) ? c[i] : cc[k]; s[k * 12 + r] = silu_f(v); }
    __syncthreads();
    for (int item = item0; item < NMOD / 32; item += gridDim.x) {
        if (item != item0) { const float* wp = wm + (size_t)(kg * 64) * NMOD + item * 32 + (t & 31);
#pragma unroll
            for (int k = 0; k < 64; ++k) w[k] = __builtin_nontemporal_load(wp + (size_t)k * NMOD); }
        float acc[9];
#pragma unroll
        for (int r = 0; r < 9; ++r) acc[r] = 0.f;
#pragma unroll
        for (int k = 0; k < 64; ++k) {
            const float* sp = s + (kg * 64 + k) * 12; const f32x4 s0 = *(const f32x4*)sp, s1 = *(const f32x4*)(sp + 4); const float s8 = sp[8];
            acc[0] += s0.x * w[k]; acc[1] += s0.y * w[k]; acc[2] += s0.z * w[k]; acc[3] += s0.w * w[k];
            acc[4] += s1.x * w[k]; acc[5] += s1.y * w[k]; acc[6] += s1.z * w[k]; acc[7] += s1.w * w[k]; acc[8] += s8 * w[k];
        }
#pragma unroll
        for (int r = 0; r < 9; ++r) red[(kg * 9 + r) * 32 + (t & 31)] = acc[r];
        __syncthreads();
        if (t < 9 * 32) {
            const int r = t >> 5, cl = t & 31; float v = 0.f;
#pragma unroll
            for (int g = 0; g < 16; ++g) v += red[(g * 9 + r) * 32 + cl];
            __hip_atomic_store((unsigned*)MOD + r * NMOD + item * 32 + cl, __float_as_uint(v + bm[item * 32 + cl]), __ATOMIC_RELAXED, __HIP_MEMORY_SCOPE_AGENT);
        }
        __syncthreads();
        if (t == 0 && item < MOD_PRE_ITEMS) __hip_atomic_fetch_add((unsigned*)(a.ws + WS_PCNT) + 64 * 8, 1u, __ATOMIC_RELAXED, __HIP_MEMORY_SCOPE_AGENT);
    }
}
__device__ __forceinline__ void mod_pre_wait(const Args& a) {
    if (threadIdx.x == 0) {
        unsigned* cnt = (unsigned*)(a.ws + WS_PCNT) + 64 * 8; unsigned sp = 0;
        while (__hip_atomic_load(cnt, __ATOMIC_RELAXED, __HIP_MEMORY_SCOPE_AGENT) < (unsigned)MOD_PRE_ITEMS) { __builtin_amdgcn_s_sleep(1); if (++sp > (1u << 22)) break; }
        __builtin_amdgcn_fence(__ATOMIC_ACQUIRE, "agent");
        asm volatile("s_waitcnt vmcnt(0)" ::: "memory");
    }
    __syncthreads();
}

struct TItem { const float* W; int K, N, n0, k0, rowoff, gu; const float* kscale; float cs_lo; int cs_n; bf16_t* WT; };
typedef short wv4i16_t __attribute__((ext_vector_type(4)));
__device__ __forceinline__ void titem_load(const TItem& I, f32x4 (&r)[8], int lane) {
    const float* p = I.W + (size_t)(I.k0 + (lane >> 3)) * I.N + I.n0 + 4 * (lane & 7);
#pragma unroll
    for (int i = 0; i < 8; ++i) r[i] = __builtin_nontemporal_load((const f32x4*)(p + (size_t)(8 * i) * I.N));
}
template <bool KSC>
__device__ __forceinline__ void titem_store(const TItem& I, const f32x4 (&r)[8], unsigned scr, int lane) {
    float cs[4] = {1.f, 1.f, 1.f, 1.f};
    if (KSC) {
#pragma unroll
        for (int c = 0; c < 4; ++c) cs[c] = (I.n0 + 4 * (lane & 7) + c < I.cs_n) ? I.cs_lo : 1.f; }
#pragma unroll
    for (int i = 0; i < 8; ++i) {
        f32x4 v = r[i];
        if (KSC) { const float ks = I.kscale ? I.kscale[I.k0 + 8 * i + (lane >> 3)] : 1.f; v.x *= ks * cs[0]; v.y *= ks * cs[1]; v.z *= ks * cs[2]; v.w *= ks * cs[3]; }
        u32x2 w; w.x = cvtpk(v.x, v.y); w.y = cvtpk(v.z, v.w);
        asm volatile("ds_write_b64 %0, %1 offset:%c2" :: "v"(scr + lane * 8), "v"(w), "i"(i * 512) : "memory");
    }
    const int g = lane >> 4, li = lane & 15, c = g & 1;
    const unsigned ra = scr + ((li >> 2) * 64 + 32 * c + (li & 3) * 8) + (g >> 1) * 2048;
    wv4i16_t lo[4], hi[4];
    asm volatile("s_waitcnt lgkmcnt(0)" ::: "memory");
#pragma unroll
    for (int it = 0; it < 4; ++it)
        asm volatile("ds_read_b64_tr_b16 %0, %2 offset:%c3\n\tds_read_b64_tr_b16 %1, %2 offset:%c4" : "=&v"(lo[it]), "=&v"(hi[it]) : "v"(ra), "i"(it * 512), "i"(it * 512 + 256) : "memory");
    asm volatile("s_waitcnt lgkmcnt(0)" ::: "memory"); __builtin_amdgcn_sched_barrier(0);
    const int nn = I.n0 + 16 * c + li, orow = I.rowoff + (I.gu ? ((nn >> 7) * 256 + (nn & 127)) : nn);
    if (KSC) {
        bf16_t* op = I.WT + (size_t)orow * I.K + I.k0 + (g >> 1) * 32;
#pragma unroll
        for (int it = 0; it < 4; ++it) { const bf16x8 o = (bf16x8){lo[it][0], lo[it][1], lo[it][2], lo[it][3], hi[it][0], hi[it][1], hi[it][2], hi[it][3]}; *(bf16x8*)(op + 8 * it) = o; }
    } else {
        unsigned char* op = (unsigned char*)I.WT + (size_t)orow * I.K + I.k0 + (g >> 1) * 32;
#pragma unroll
        for (int it = 0; it < 4; ++it) {
            u32x2 o;
            o.x = cvt4_fp8(bf2f((bf16_t)lo[it][0]) * W8_SCALE, bf2f((bf16_t)lo[it][1]) * W8_SCALE, bf2f((bf16_t)lo[it][2]) * W8_SCALE, bf2f((bf16_t)lo[it][3]) * W8_SCALE);
            o.y = cvt4_fp8(bf2f((bf16_t)hi[it][0]) * W8_SCALE, bf2f((bf16_t)hi[it][1]) * W8_SCALE, bf2f((bf16_t)hi[it][2]) * W8_SCALE, bf2f((bf16_t)hi[it][3]) * W8_SCALE);
            *(u32x2*)(op + 8 * it) = o;
        }
    }
}
__device__ __forceinline__ void titem8_load(const TItem& I, f32x4 (&r)[8], int lane) {
    const float* p = I.W + (size_t)(I.k0 + 2 * (lane >> 3)) * I.N + I.n0 + 4 * (lane & 7);
#pragma unroll
    for (int i = 0; i < 4; ++i) { r[2 * i] = __builtin_nontemporal_load((const f32x4*)(p + (size_t)(16 * i) * I.N)); r[2 * i + 1] = __builtin_nontemporal_load((const f32x4*)(p + (size_t)(16 * i + 1) * I.N)); }
}
__device__ __forceinline__ float sc8(float v) { return __builtin_amdgcn_fmed3f(v * W8_SCALE, -448.f, 448.f); }
__device__ __forceinline__ unsigned char* titem8_outptr(const TItem& I, int lane) {
    const int g = lane >> 4, li = lane & 15, c = g & 1;
    const int nn = I.n0 + 16 * c + li, orow = I.rowoff + (I.gu ? ((nn >> 7) * 256 + (nn & 127)) : nn);
    return (unsigned char*)I.WT + (size_t)orow * I.K + I.k0 + (g >> 1) * 32;
}
__device__ __forceinline__ void titem8_store(unsigned char* op, const f32x4 (&r)[8], unsigned scr, int lane, bool doit = true) {
#pragma unroll
    for (int i = 0; i < 4; ++i) {
        const f32x4 ra = r[2 * i], rb = r[2 * i + 1];
        int w0 = __builtin_amdgcn_cvt_pk_fp8_f32(sc8(ra.x), sc8(rb.x), 0, false); w0 = __builtin_amdgcn_cvt_pk_fp8_f32(sc8(ra.y), sc8(rb.y), w0, true);
        int w1 = __builtin_amdgcn_cvt_pk_fp8_f32(sc8(ra.z), sc8(rb.z), 0, false); w1 = __builtin_amdgcn_cvt_pk_fp8_f32(sc8(ra.w), sc8(rb.w), w1, true);
        u32x2 w; w.x = (unsigned)w0; w.y = (unsigned)w1;
        asm volatile("ds_write_b64 %0, %1 offset:%c2" :: "v"(scr + lane * 8), "v"(w), "i"(i * 512) : "memory");
    }
    const int g = lane >> 4, li = lane & 15, c = g & 1;
    const unsigned ra_ = scr + ((li >> 2) * 64 + 32 * c + (li & 3) * 8) + (g >> 1) * 1024;
    wv4i16_t lo[2], hi[2];
    asm volatile("s_waitcnt lgkmcnt(0)" ::: "memory");
#pragma unroll
    for (int it = 0; it < 2; ++it)
        asm volatile("ds_read_b64_tr_b16 %0, %2 offset:%c3\n\tds_read_b64_tr_b16 %1, %2 offset:%c4" : "=&v"(lo[it]), "=&v"(hi[it]) : "v"(ra_), "i"(it * 512), "i"(it * 512 + 256) : "memory");
    asm volatile("s_waitcnt lgkmcnt(0)" ::: "memory"); __builtin_amdgcn_sched_barrier(0);
#pragma unroll
    for (int it = 0; it < 2; ++it) { const bf16x8 o = (bf16x8){lo[it][0], lo[it][1], lo[it][2], lo[it][3], hi[it][0], hi[it][1], hi[it][2], hi[it][3]}; if (doit) *(bf16x8*)(op + 16 * it) = o; }
}
constexpr int WI_IN = (DM / 64) * (DIN / 32), WI_OUT = (DM / 64) * (DM / 32), WI_G = (DM / 64) * (DE / 32), WI_D = (DE / 64) * (DM / 32);
constexpr int WI_DENSE = WI_IN + WI_OUT, WI_GU = NE * 2 * WI_G, WI_DN = NE * WI_D, WI_MOE = WI_GU + WI_DN;
#ifndef INPROJ_ITEMS_V
#define INPROJ_ITEMS_V 4096
#endif
constexpr int WI_SIDE = INPROJ_ITEMS_V;
constexpr int WI_MIX_END = WI_DENSE + WI_MOE - WI_SIDE;
__device__ __forceinline__ TItem wconv_item(const Args& a, int it) {
    bf16_t* WIN = (bf16_t*)(a.ws + WS_WIN); bf16_t* WOUT = (bf16_t*)(a.ws + WS_WOUT); bf16_t* W1 = (bf16_t*)(a.ws + WS_W1); bf16_t* W2 = (bf16_t*)(a.ws + WS_W2);
    TItem I; I.kscale = nullptr; I.cs_lo = 1.f; I.cs_n = 0; I.rowoff = 0; I.gu = 0;
    int r = it;
    if (r < WI_IN) { I.W = a.in[7]; I.K = DM; I.N = DIN; I.WT = WIN; I.cs_lo = QSCALE; I.cs_n = DNA; I.k0 = 64 * (r / (DIN / 32)); I.n0 = 32 * (r % (DIN / 32)); }
    else if ((r -= WI_IN) < WI_OUT) { I.W = a.in[14]; I.K = DM; I.N = DM; I.WT = WOUT; const int kb = r / (DM / 32); I.kscale = (kb * 64 < DNA) ? a.in[12] : (a.in[13] - DNA); I.k0 = 64 * kb; I.n0 = 32 * (r % (DM / 32)); }
    else { r -= WI_OUT;
        if (r < WI_GU) { const int e = r / (2 * WI_G); r -= e * (2 * WI_G); const int up = r / WI_G; r -= up * WI_G; I.W = (up ? a.in[18] : a.in[17]) + (size_t)e * DM * DE; I.K = DM; I.N = DE; I.WT = (bf16_t*)((unsigned char*)W1 + (size_t)e * 3072 * DM); I.gu = 1; I.rowoff = 128 * up; I.k0 = 64 * (r / (DE / 32)); I.n0 = 32 * (r % (DE / 32)); }
        else { r -= WI_GU; const int e = r / WI_D; r -= e * WI_D; I.W = a.in[19] + (size_t)e * DE * DM; I.K = DE; I.N = DM; I.WT = (bf16_t*)((unsigned char*)W2 + (size_t)e * DM * DE); I.k0 = 64 * (r / (DM / 32)); I.n0 = 32 * (r % (DM / 32)); } }
    return I;
}
__device__ __forceinline__ TItem wdown_item(const Args& a, int r) {
    TItem I; I.kscale = nullptr; I.cs_lo = 1.f; I.cs_n = 0; I.rowoff = 0; I.gu = 0;
    const int e = r / WI_D; r -= e * WI_D; I.W = a.in[19] + (size_t)e * DE * DM; I.K = DE; I.N = DM; I.WT = (bf16_t*)(a.ws + WS_W2 + (size_t)e * DM * DE); I.k0 = 64 * (r / (DM / 32)); I.n0 = 32 * (r % (DM / 32));
    return I;
}
template <bool KSC>
__device__ __forceinline__ void wconv_range(const Args& a, unsigned scr, int it, int last, int stride, int lane) {
    if (it >= last) return;
    f32x4 ra[8], rb[8];
    TItem Ia = wconv_item(a, it), Ib = Ia;
    if (KSC) titem_load(Ia, ra, lane); else titem8_load(Ia, ra, lane);
    for (; it < last; it += 2 * stride) {
        const bool hb = it + stride < last;
        if (hb) { Ib = wconv_item(a, it + stride); if (KSC) titem_load(Ib, rb, lane); else titem8_load(Ib, rb, lane); }
        if (KSC) titem_store<true>(Ia, ra, scr, lane); else titem8_store(titem8_outptr(Ia, lane), ra, scr, lane);
        if (!hb) break;
        const bool ha = it + 2 * stride < last;
        if (ha) { Ia = wconv_item(a, it + 2 * stride); if (KSC) titem_load(Ia, ra, lane); else titem8_load(Ia, ra, lane); }
        if (KSC) titem_store<true>(Ib, rb, scr, lane); else titem8_store(titem8_outptr(Ib, lane), rb, scr, lane);
        if (!ha) break;
    }
}
__device__ __forceinline__ void wconv_stream4(const Args& a, unsigned scr, int it, int last, int stride, int lane) {
    f32x4 r0[8], r1[8], r2[8], r3[8];
    if (it < last) titem8_load(wconv_item(a, it), r0, lane);
    if (it + stride < last) titem8_load(wconv_item(a, it + stride), r1, lane);
    if (it + 2 * stride < last) titem8_load(wconv_item(a, it + 2 * stride), r2, lane);
    if (it + 3 * stride < last) titem8_load(wconv_item(a, it + 3 * stride), r3, lane);
#define WCS_STEP(R, D) { const int i_ = it + (D) * stride; if (i_ >= last) break;                \
        { const TItem I = wconv_item(a, i_); titem8_store(titem8_outptr(I, lane), R, scr, lane); } \
        if (i_ + 4 * stride < last) titem8_load(wconv_item(a, i_ + 4 * stride), R, lane); }
    for (;; it += 4 * stride) { WCS_STEP(r0, 0) WCS_STEP(r1, 1) WCS_STEP(r2, 2) WCS_STEP(r3, 3) }
#undef WCS_STEP
}
__device__ __forceinline__ void phase_wconv(const Args& a, float* lds) {
    const int wave = __builtin_amdgcn_readfirstlane(threadIdx.x >> 6), lane = threadIdx.x & 63;
    const unsigned scr = (unsigned)(size_t)(__attribute__((address_space(3))) unsigned char*)(lds) + 65536 + wave * 4096;
    const int G = gridDim.x, nmod = NMOD / 32, free_wgs = G - nmod;
    if (free_wgs >= 32) { if ((int)blockIdx.x >= nmod) wconv_range<true>(a, scr, ((int)blockIdx.x - nmod) * 8 + wave, WI_DENSE, free_wgs * 8, lane); }
    else wconv_range<true>(a, scr, blockIdx.x * 8 + wave, WI_DENSE, G * 8, lane);
}

__device__ __forceinline__ const float* prenorm_row(const Args& a, int m) { return (m < NTOK) ? a.in[0] + (size_t)m * DM : a.in[2] + (size_t)(m - NTOK) * DM; }
__device__ __forceinline__ void prenorm_one(bf16_t* H, int m, const f32x4 (&v)[4], const f32x4 (&ga)[4], const f32x4 (&gb)[4], int lane) {
    float s = 0.f;
#pragma unroll
    for (int j = 0; j < 4; ++j) s += (v[j].x * v[j].x + v[j].y * v[j].y) + (v[j].z * v[j].z + v[j].w * v[j].w);
    const float rstd = rsqrtf(wave_sum(s) * (1.f / DM) + EPS);
    u32x2* o = (u32x2*)(H + (size_t)m * DM) + lane;
#pragma unroll
    for (int j = 0; j < 4; ++j) { const f32x4 y = (v[j] * rstd) * ga[j] + gb[j]; u32x2 w; w.x = cvtpk(y.x, y.y); w.y = cvtpk(y.z, y.w); o[64 * j] = w; }
}
__device__ __forceinline__ void phase_prenorm(const Args& a) {
    const int wave = threadIdx.x >> 6, lane = threadIdx.x & 63;
    const int gw = blockIdx.x * 8 + wave, NGW = gridDim.x * 8;
    const float* MOD = (const float*)(a.ws + WS_MOD); bf16_t* H = (bf16_t*)(a.ws + WS_H);
    const f32x4* n1 = (const f32x4*)a.in[6] + lane;
    const int NR = NTOK + NCTX, per = (NR + NGW - 1) / NGW, mbeg = gw * per, mend = (mbeg + per < NR) ? mbeg + per : NR;
    int mrcur = -1; f32x4 ga[4], gb[4];
    for (int m = mbeg; m < mend; m += 3) {
        const int nrow = (mend - m < 3) ? (mend - m) : 3;
        f32x4 v[3][4];
#pragma unroll
        for (int r = 0; r < 3; ++r) if (r < nrow) { const f32x4* xr = (const f32x4*)prenorm_row(a, m + r) + lane;
#pragma unroll
            for (int j = 0; j < 4; ++j) v[r][j] = __builtin_nontemporal_load(xr + 64 * j); }
#pragma unroll
        for (int r = 0; r < 3; ++r) if (r < nrow) {
            const int mm = m + r, mr = (mm < NTOK) ? mm / SEQ : 8;
            if (mr != mrcur) {
                const f32x4* sh = (const f32x4*)(MOD + mr * NMOD) + lane; const f32x4* sc = (const f32x4*)(MOD + mr * NMOD + DM) + lane;
#pragma unroll
                for (int j = 0; j < 4; ++j) { ga[j] = n1[64 * j] * (sc[64 * j] + 1.f); gb[j] = sh[64 * j]; }
                mrcur = mr;
            }
            prenorm_one(H, mm, v[r], ga, gb, lane);
        }
    }
}

__device__ __forceinline__ void norm2_blocks(const Args& a, float* lds, int blk0, int blk1, int bstride) {
    const int tid = threadIdx.x, wave = tid >> 6, lane = tid & 63, e = lane & 15, kq = lane >> 4;
    const float* MOD = (const float*)(a.ws + WS_MOD); unsigned char* H8 = a.ws + WS_H2; float* AFF = (float*)(a.ws + WS_AFF);
    float* ybuf = lds;
    float* part = lds + 16 * 1028;
    constexpr int YP = 1028;
    float wreg[32];
    {   const float* wp = a.in[16] + (size_t)(128 * wave + 4 * kq) * NE + e;
#pragma unroll
        for (int j = 0; j < 8; ++j)
#pragma unroll
            for (int i = 0; i < 4; ++i) wreg[4 * j + i] = wp[(16 * j + i) * NE]; }
    const f32x4* n2 = (const f32x4*)a.in[15] + lane;
    const bf16_t* XNB = (const bf16_t*)(a.ws + WS_XNB);
    for (int blk = blk0; blk < blk1; blk += bstride) {
        const int row0 = blk * 64, b = row0 / SEQ;
        f32x4 ga[4], gb[4];
        {   const f32x4* sh = (const f32x4*)(MOD + b * NMOD + 3 * DM) + lane; const f32x4* sc = (const f32x4*)(MOD + b * NMOD + 4 * DM) + lane;
#pragma unroll
            for (int j = 0; j < 4; ++j) { ga[j] = n2[64 * j] * (sc[64 * j] + 1.f); gb[j] = sh[64 * j]; } }
        u32x2 vn[2][4];
#pragma unroll
        for (int r = 0; r < 2; ++r) { const u32x2* xr = (const u32x2*)(XNB + (size_t)(row0 + 8 * r + wave) * DM) + lane;
#pragma unroll
            for (int j = 0; j < 4; ++j) vn[r][j] = xr[64 * j]; }
        for (int t = 0; t < 4; ++t) {
            f32x4 v[2][4];
#pragma unroll
            for (int r = 0; r < 2; ++r)
#pragma unroll
                for (int j = 0; j < 4; ++j) v[r][j] = (f32x4){bflo(vn[r][j].x), bfhi(vn[r][j].x), bflo(vn[r][j].y), bfhi(vn[r][j].y)};
            if (t + 1 < 4) {
#pragma unroll
                for (int r = 0; r < 2; ++r) { const u32x2* xr = (const u32x2*)(XNB + (size_t)(row0 + 16 * (t + 1) + 8 * r + wave) * DM) + lane;
#pragma unroll
                    for (int j = 0; j < 4; ++j) vn[r][j] = xr[64 * j]; } }
#pragma unroll
            for (int r = 0; r < 2; ++r) {
                const int m = row0 + 16 * t + 8 * r + wave;
                float s = 0.f;
#pragma unroll
                for (int j = 0; j < 4; ++j) s += (v[r][j].x * v[r][j].x + v[r][j].y * v[r][j].y) + (v[r][j].z * v[r][j].z + v[r][j].w * v[r][j].w);
                const float rstd = rsqrtf(wave_sum(s) * (1.f / DM) + EPS);
                unsigned* o = (unsigned*)(H8 + (size_t)m * DM) + lane;
#pragma unroll
                for (int j = 0; j < 4; ++j) {
                    const f32x4 y = (v[r][j] * rstd) * ga[j] + gb[j];
                    o[64 * j] = cvt4_fp8(y.x * A8_SCALE, y.y * A8_SCALE, y.z * A8_SCALE, y.w * A8_SCALE);
                    *((f32x4*)(ybuf + (8 * r + wave) * YP) + 64 * j + lane) = y;
                }
            }
            LDS_BARRIER();
            {
                f32x4 D0 = (f32x4){0.f, 0.f, 0.f, 0.f}, D1 = D0;
                const float* yp = ybuf + e * YP + 128 * wave + 4 * kq;
#pragma unroll
                for (int j = 0; j < 8; ++j) { const f32x4 y4 = *(const f32x4*)(yp + 16 * j);
                    D0 = __builtin_amdgcn_mfma_f32_16x16x4f32(wreg[4 * j + 0], y4.x, D0, 0, 0, 0); D1 = __builtin_amdgcn_mfma_f32_16x16x4f32(wreg[4 * j + 1], y4.y, D1, 0, 0, 0);
                    D0 = __builtin_amdgcn_mfma_f32_16x16x4f32(wreg[4 * j + 2], y4.z, D0, 0, 0, 0); D1 = __builtin_amdgcn_mfma_f32_16x16x4f32(wreg[4 * j + 3], y4.w, D1, 0, 0, 0); }
                *(f32x4*)(part + ((lane & 15) * 8 + wave) * 16 + 4 * kq) = D0 + D1;
            }
            LDS_BARRIER();
            if (tid < 256) {
                const int rr = tid >> 4;
                float lg = 0.f;
#pragma unroll
                for (int w = 0; w < 8; ++w) lg += part[(rr * 8 + w) * 16 + e];
                float mx = lg;
#pragma unroll
                for (int o2 = 1; o2 < 16; o2 <<= 1) mx = fmaxf(mx, __shfl_xor(mx, o2));
                const float ex = __expf(lg - mx); float den = ex;
#pragma unroll
                for (int o2 = 1; o2 < 16; o2 <<= 1) den += __shfl_xor(den, o2);
                const int n = (row0 + 16 * t + rr) % SEQ;
                __hip_atomic_store((unsigned*)AFF + ((size_t)b * NE + e) * SEQ + n, __float_as_uint(ex / den), __ATOMIC_RELAXED, __HIP_MEMORY_SCOPE_AGENT);
            }
        }
        LDS_BARRIER();
    }
}

__device__ __forceinline__ void phase_norm2(const Args& a, float* lds) { norm2_blocks(a, lds, blockIdx.x, NTOK / 64, gridDim.x); }

__device__ __forceinline__ int wave_incl_scan(int v, int lane) {
#pragma unroll
    for (int o = 1; o < 64; o <<= 1) { const int u = __shfl_up(v, o); if (lane >= o) v += u; }
    return v;
}
__device__ __forceinline__ void topk_items(const Args& a, float* lds, int item0, int item1, int istride) {
    const int t = threadIdx.x, wave = t >> 6, lane = t & 63;
    const float* AFF = (const float*)(a.ws + WS_AFF); float* GATE = (float*)(a.ws + WS_GATE); int* SEL = (int*)(a.ws + WS_SEL);
    int* IDX = (int*)(a.ws + WS_IDX);
    int* cntw = (int*)lds;
    int* wtot = (int*)(lds + 384);
    int* list = (int*)(lds + 320);
    int* cnt = (int*)(lds + 320 + 256);
    for (int item = item0; item < item1; item += istride) {
        const int half = item & 1, e = (item >> 1) & 15, b = item >> 5;
        const u32x4 k4 = ((const u32x4*)(AFF + ((size_t)b * NE + e) * SEQ))[t];
        unsigned prefix = 0u;
        for (int rnd = 0; rnd < 16; ++rnd) {
            const int lo = 29 - 2 * rnd;
            const unsigned b1 = (lo >= 0) ? (1u << lo) : 0u, b2 = (lo >= 0) ? (2u << lo) : 1u;
            const unsigned c1 = prefix | b1, c2 = prefix | b2, c3 = prefix | b1 | b2;
            int n1 = __builtin_popcountll(__ballot(k4.x >= c1)) + __builtin_popcountll(__ballot(k4.y >= c1)) + __builtin_popcountll(__ballot(k4.z >= c1)) + __builtin_popcountll(__ballot(k4.w >= c1));
            int n2 = __builtin_popcountll(__ballot(k4.x >= c2)) + __builtin_popcountll(__ballot(k4.y >= c2)) + __builtin_popcountll(__ballot(k4.z >= c2)) + __builtin_popcountll(__ballot(k4.w >= c2));
            int n3 = __builtin_popcountll(__ballot(k4.x >= c3)) + __builtin_popcountll(__ballot(k4.y >= c3)) + __builtin_popcountll(__ballot(k4.z >= c3)) + __builtin_popcountll(__ballot(k4.w >= c3));
            if (lane == 0) { cntw[(rnd * 3 + 0) * 8 + wave] = n1; cntw[(rnd * 3 + 1) * 8 + wave] = n2; cntw[(rnd * 3 + 2) * 8 + wave] = n3; }
            __syncthreads();
            int t1 = 0, t2 = 0, t3 = 0;
#pragma unroll
            for (int w = 0; w < 8; ++w) { t1 += cntw[(rnd * 3 + 0) * 8 + w]; t2 += cntw[(rnd * 3 + 1) * 8 + w]; t3 += cntw[(rnd * 3 + 2) * 8 + w]; }
            if (lo >= 0) prefix = (t3 >= CAP) ? c3 : ((t2 >= CAP) ? c2 : ((t1 >= CAP) ? c1 : prefix));
            else prefix = (t2 >= CAP) ? c2 : prefix;
        }
        const unsigned T = prefix;
        const int g0 = k4.x > T, g1 = k4.y > T, g2 = k4.z > T, g3 = k4.w > T;
        const int e0 = k4.x == T, e1 = k4.y == T, e2 = k4.z == T, e3 = k4.w == T;
        const int cg = g0 + g1 + g2 + g3, ce = e0 + e1 + e2 + e3;
        const int sg = wave_incl_scan(cg, lane), se = wave_incl_scan(ce, lane);
        if (lane == 63) { wtot[wave] = sg; wtot[8 + wave] = se; }
        __syncthreads();
        int gbase = 0, ebase = 0, ngt = 0;
#pragma unroll
        for (int w = 0; w < 8; ++w) { const int x = wtot[w], y = wtot[8 + w]; ngt += x; if (w < wave) { gbase += x; ebase += y; } }
        int gpos = gbase + sg - cg, epos = ebase + se - ce; const int need = CAP - ngt;
        int sl[4];
        sl[0] = g0 ? gpos : ((e0 && epos < need) ? ngt + epos : -1); gpos += g0; epos += e0;
        sl[1] = g1 ? gpos : ((e1 && epos < need) ? ngt + epos : -1); gpos += g1; epos += e1;
        sl[2] = g2 ? gpos : ((e2 && epos < need) ? ngt + epos : -1); gpos += g2; epos += e2;
        sl[3] = g3 ? gpos : ((e3 && epos < need) ? ngt + epos : -1);
        if ((t >> 8) == half) {
            const unsigned kk[4] = {k4.x, k4.y, k4.z, k4.w};
#pragma unroll
            for (int i = 0; i < 4; ++i) {
                const int n = 4 * t + i;
                SEL[((size_t)b * SEQ + n) * NE + e] = sl[i];
                if (sl[i] >= 0) { GATE[(b * NE + e) * CAP + sl[i]] = __uint_as_float(kk[i]); IDX[(e * NB + b) * CAP + sl[i]] = b * SEQ + n; }
            }
        }
        __syncthreads();
    }
}

__device__ __forceinline__ void phase_topk(const Args& a, float* lds) { topk_items(a, lds, blockIdx.x, NB * NE * 2, gridDim.x); }
__device__ __forceinline__ void phase_norm2_topk(const Args& a, float* lds) {
    const int blk = blockIdx.x, b = blk >> 5;
    norm2_blocks(a, lds, blk, blk + 1, 1);
    asm volatile("s_waitcnt vmcnt(0)" ::: "memory");
    LDS_BARRIER();
    if (threadIdx.x == 0) {
        unsigned* cnt = (unsigned*)(a.ws + WS_PCNT) + 64 * b;
        __hip_atomic_fetch_add(cnt, 1u, __ATOMIC_RELAXED, __HIP_MEMORY_SCOPE_AGENT);
        unsigned sp = 0;
        while (__hip_atomic_load(cnt, __ATOMIC_RELAXED, __HIP_MEMORY_SCOPE_AGENT) < 32u) { __builtin_amdgcn_s_sleep(1); if (++sp > (1u << 22)) break; }
        __builtin_amdgcn_fence(__ATOMIC_ACQUIRE, "agent");
        asm volatile("s_waitcnt vmcnt(0)" ::: "memory");
    }
    LDS_BARRIER();
    const int item = b * 32 + (blk & 31);
    topk_items(a, lds, item, item + 1, 1);
}

__device__ __forceinline__ void final_gather(const Args& a, int m, int mysel, f32x4 (&acc)[4], int lane) {
    const unsigned char* Y = a.ws + WS_Y; const int b = m / SEQ;
#pragma unroll
    for (int j = 0; j < 4; ++j) acc[j] = (f32x4){0.f, 0.f, 0.f, 0.f};
    unsigned long long msk = __ballot(mysel >= 0);
    while (msk) {
        const int e = __builtin_ctzll(msk); msk &= msk - 1;
        const int sl = __shfl(mysel, e);
        const unsigned* yr = (const unsigned*)(Y + (size_t)((e * NB + b) * CAP + sl) * DM) + lane;
#pragma unroll
        for (int j = 0; j < 4; ++j) { const unsigned w = yr[64 * j]; const f32x2 lo = __builtin_amdgcn_cvt_pk_f32_fp8((int)w, false), hi = __builtin_amdgcn_cvt_pk_f32_fp8((int)w, true);
            acc[j].x += lo.x; acc[j].y += lo.y; acc[j].z += hi.x; acc[j].w += hi.y; }
    }
#pragma unroll
    for (int j = 0; j < 4; ++j) acc[j] = acc[j] * (1.f / Y8_SCALE);
}
__device__ __forceinline__ void final_finish(const Args& a, float* dst, int m, const f32x4 (&xv)[4], const f32x4 (&acc)[4], int lane) {
    const float* MOD = (const float*)(a.ws + WS_MOD); const int b = m / SEQ;
    const f32x4* nf = (const f32x4*)a.in[20] + lane; const f32x4* g2 = (const f32x4*)(MOD + b * NMOD + 5 * DM) + lane;
    f32x4* xr = (f32x4*)(dst + (size_t)m * DM) + lane;
    f32x4 v[4]; float s = 0.f;
#pragma unroll
    for (int j = 0; j < 4; ++j) { v[j] = xv[j] + g2[64 * j] * acc[j]; s += (v[j].x * v[j].x + v[j].y * v[j].y) + (v[j].z * v[j].z + v[j].w * v[j].w); }
    const float rstd = rsqrtf(wave_sum(s) * (1.f / DM) + EPS);
#pragma unroll
    for (int j = 0; j < 4; ++j) __builtin_nontemporal_store((v[j] * rstd) * nf[64 * j], xr + 64 * j);
}
__device__ __forceinline__ void phase_final(const Args& a, float* dst) {
    const int wave = threadIdx.x >> 6, lane = threadIdx.x & 63;
    const int gw = blockIdx.x * 8 + wave, NGW = gridDim.x * 8;
    const int* SEL = (const int*)(a.ws + WS_SEL);
    const int per = (NTOK + NGW - 1) / NGW, mbeg = gw * per, mend = (mbeg + per < NTOK) ? mbeg + per : NTOK;
    for (int m = mbeg; m < mend; m += 3) {
        const int m2 = m + 1, m3 = m + 2; const bool two = m2 < mend, three = m3 < mend;
        const int s0 = (lane < NE) ? SEL[(size_t)m * NE + lane] : -1;
        const int s1 = (two && lane < NE) ? SEL[(size_t)m2 * NE + lane] : -1;
        const int s2 = (three && lane < NE) ? SEL[(size_t)m3 * NE + lane] : -1;
        f32x4 x0[4], x1[4], x2[4], a0[4], a1[4], a2[4];
        { const u32x2* xr = (const u32x2*)((const bf16_t*)(a.ws + WS_XNB) + (size_t)m * DM) + lane;
#pragma unroll
          for (int j = 0; j < 4; ++j) { const u32x2 w = xr[64 * j]; x0[j] = (f32x4){bflo(w.x), bfhi(w.x), bflo(w.y), bfhi(w.y)}; } }
        if (two) { const u32x2* xr = (const u32x2*)((const bf16_t*)(a.ws + WS_XNB) + (size_t)m2 * DM) + lane;
#pragma unroll
          for (int j = 0; j < 4; ++j) { const u32x2 w = xr[64 * j]; x1[j] = (f32x4){bflo(w.x), bfhi(w.x), bflo(w.y), bfhi(w.y)}; } }
        if (three) { const u32x2* xr = (const u32x2*)((const bf16_t*)(a.ws + WS_XNB) + (size_t)m3 * DM) + lane;
#pragma unroll
          for (int j = 0; j < 4; ++j) { const u32x2 w = xr[64 * j]; x2[j] = (f32x4){bflo(w.x), bfhi(w.x), bflo(w.y), bfhi(w.y)}; } }
        final_gather(a, m, s0, a0, lane);
        if (two) final_gather(a, m2, s1, a1, lane);
        if (three) final_gather(a, m3, s2, a2, lane);
        final_finish(a, dst, m, x0, a0, lane);
        if (two) final_finish(a, dst, m2, x1, a1, lane);
        if (three) final_finish(a, dst, m3, x2, a2, lane);
    }
}

namespace pg8 {
#define PG8_LAS __attribute__((address_space(3)))
typedef unsigned short bf16_t;
typedef short bf16x8 __attribute__((ext_vector_type(8)));
typedef float f32x4 __attribute__((ext_vector_type(4)));
typedef unsigned u32x4 __attribute__((ext_vector_type(4)));
typedef int v4i_t __attribute__((ext_vector_type(4)));
typedef int v8i_t __attribute__((ext_vector_type(8)));
constexpr int BM = 256, BK = 64, HALF = 128, HTB = HALF * BK * 2  , STAGE_BYTES = 8 * HTB, NXCD = 8, WGM = 8;

__host__ __device__ __forceinline__ int lds_byte(int r, int c) { const int st = (r >> 4) * 2 + (c >> 5), rr = r & 15, cc = c & 31, ob = rr * 64 + cc * 2; return st * 1024 + (ob ^ (((ob >> 9) & 1) << 5)); }
__host__ __device__ __forceinline__ void stage_rc(int b, int& R, int& C) { const int st = b / 1024, sb = b % 1024, swz = sb ^ (((sb >> 9) & 1) << 5); R = (st >> 1) * 16 + swz / 64; C = (st & 1) * 32 + (swz % 64) / 2; }
__host__ __device__ __forceinline__ int perm32(int rho) { const int n = rho >> 4, i = rho & 15; return 8 * (i >> 2) + 4 * n + (i & 3); }

struct Unit { int pm, pn; };
struct Gemm { const bf16_t* A; const bf16_t* Bt; int M, N, K; const int* gidx; };
struct HostW { const Args* a; int first, stride, last; unsigned scr; };
template <class Epi, class Sched, bool ALIGN_EPI = false, bool SP2 = false, bool GATHER = false, bool F8 = false, bool HOST = false>
__device__ __forceinline__ void gemm_phase(PG8_LAS unsigned char* lds, const Gemm g, const Sched& S, const Epi& E, const HostW hw = HostW{nullptr, 0, 0, 0, 0u}) {
    const int tid = threadIdx.x, wid = __builtin_amdgcn_readfirstlane(tid >> 6), lane = tid & 63, wr = wid >> 2, wc = wid & 3, fr = lane & 15, fq = lane >> 4;
    const int K = g.K, nt = K / BK;
    unsigned voffA[2], voffB[2];
#pragma unroll
    for (int i = 0; i < 2; ++i) { int R, C; stage_rc(tid * 16 + i * 8192, R, C); const int Rb = Epi::PERM ? ((R & ~31) + perm32(R & 31)) : R;
        voffA[i] = (unsigned)(R * K + C) * 2u; voffB[i] = (unsigned)(Rb * K + C) * 2u; }
    const size_t kstep = (size_t)(BK * 2);
    const size_t hstep = (size_t)HALF * K * 2;
    const size_t tstep = 2 * hstep;
    const unsigned ldsw = (unsigned)wid * 1024u;
    const int aoff = lds_byte(wr * 64 + fr, fq * 8), boff = lds_byte(wc * 32 + fr, fq * 8);
    const int sc8 = 0x7F7F7F7F;
    constexpr int KSTEP_B = 1024;
#define PG8_SA(b, h) (((b) * 2 + (h)) * HTB)
#define PG8_SB(b, h) ((4 + (b) * 2 + (h)) * HTB)
#define PG8_STAGE(bufoff, gbase, voff) do { _Pragma("unroll") for (int _i = 0; _i < 2; ++_i) \
        __builtin_amdgcn_global_load_lds((const unsigned*)((const char*)(gbase) + (voff)[_i]), (PG8_LAS unsigned*)(lds + (bufoff) + ldsw + _i * 8192), 16, 0, 0); } while (0)
    unsigned vAc[2][2], vAn[2][2], vA2[2][2];
#define PG8_GIDX(dst, pm_) do { _Pragma("unroll") for (int _h = 0; _h < 2; ++_h) _Pragma("unroll") for (int _i = 0; _i < 2; ++_i) { int R_, C_; stage_rc(tid * 16 + _i * 8192, R_, C_); \
        dst[_h][_i] = (unsigned)(g.gidx[(pm_) * BM + _h * HALF + R_] * K + C_) * 2u; } } while (0)
#define PG8_STAGEA(bufoff, base, h, vsel) do { if constexpr (GATHER) { PG8_STAGE(bufoff, base, vsel[h]); } else { PG8_STAGE(bufoff, (base) + (h) * hstep, voffA); } } while (0)
#define PG8_LDA(dst, b, h) do { _Pragma("unroll") for (int m = 0; m < 4; ++m) _Pragma("unroll") for (int k = 0; k < 2; ++k) dst[m][k] = *(const PG8_LAS bf16x8*)(lds + PG8_SA(b, h) + aoff + m * 2048 + k * KSTEP_B); } while (0)
#define PG8_LDB(dst, b, h) do { _Pragma("unroll") for (int n = 0; n < 2; ++n) _Pragma("unroll") for (int k = 0; k < 2; ++k) dst[n][k] = *(const PG8_LAS bf16x8*)(lds + PG8_SB(b, h) + boff + n * 2048 + k * KSTEP_B); } while (0)
#define PG8_CAT8(x, y) __builtin_shufflevector(__builtin_bit_cast(v4i_t, x), __builtin_bit_cast(v4i_t, y), 0, 1, 2, 3, 4, 5, 6, 7)
#define PG8_MMA(ai, bj, At, Bt) do { __builtin_amdgcn_s_setprio(1); _Pragma("unroll") for (int m = 0; m < 4; ++m) _Pragma("unroll") for (int n = 0; n < 2; ++n) { \
        if constexpr (F8) { const v8i_t b8_ = PG8_CAT8(Bt[n][0], Bt[n][1]), a8_ = PG8_CAT8(At[m][0], At[m][1]); \
            asm volatile("s_nop 1\n\tv_mfma_scale_f32_16x16x128_f8f6f4 %0, %1, %2, %0, %3, %3 op_sel_hi:[0,0,0]" : "+v"(acc[ai][bj][m][n]) : "v"(b8_), "v"(a8_), "v"(sc8)); } \
        else { _Pragma("unroll") for (int k = 0; k < 2; ++k) acc[ai][bj][m][n] = __builtin_amdgcn_mfma_f32_16x16x32_bf16(Bt[n][k], At[m][k], acc[ai][bj][m][n], 0, 0, 0); } } __builtin_amdgcn_s_setprio(0); } while (0)
#define PG8_WAIT_V(n) asm volatile("s_waitcnt vmcnt(" #n ")" ::: "memory")
#define PG8_WAIT_L(n) asm volatile("s_waitcnt lgkmcnt(" #n ")" ::: "memory")
#define PG8_BAR __builtin_amdgcn_s_barrier()
#define PG8_SCHED __builtin_amdgcn_sched_barrier(0)
    Unit cur, nxt; int ui = 0;
    if (!S.next(0, cur)) return;
    f32x4 acc[2][2][4][2];
#pragma unroll
    for (int a = 0; a < 2; ++a)
#pragma unroll
        for (int b = 0; b < 2; ++b)
#pragma unroll
            for (int m = 0; m < 4; ++m)
#pragma unroll
                for (int n = 0; n < 2; ++n) acc[a][b][m][n] = (f32x4){0.f, 0.f, 0.f, 0.f};
    bf16x8 At[4][2], B0[2][2], B1[2][2];
    const char* cA = (const char*)g.A + (GATHER ? (size_t)0 : (size_t)cur.pm * tstep); const char* cB = (const char*)g.Bt + (size_t)cur.pn * tstep;
    if constexpr (GATHER) { PG8_GIDX(vAc, cur.pm); }
    S.a_ready(cur);
    if constexpr (Epi::MIDSCALE) E.unit_begin(cur, ui, tid);
    if constexpr (SP2) {
        PG8_STAGE(PG8_SB(0, 0), cB, voffB); PG8_STAGE(PG8_SB(0, 1), cB + hstep, voffB); PG8_STAGEA(PG8_SA(0, 0), cA, 0, vAc); PG8_STAGEA(PG8_SA(0, 1), cA, 1, vAc);
        if (wr == 1) PG8_BAR;
        PG8_WAIT_V(2); PG8_BAR;
        PG8_STAGE(PG8_SB(1, 0), cB + kstep, voffB); PG8_STAGEA(PG8_SA(1, 0), cA + kstep, 0, vAc); PG8_STAGE(PG8_SB(1, 1), cB + hstep + kstep, voffB);
        PG8_WAIT_V(6); PG8_BAR;
    } else {
        PG8_STAGE(PG8_SB(0, 0), cB, voffB); PG8_STAGE(PG8_SA(0, 0), cA, voffA); PG8_STAGE(PG8_SB(0, 1), cB + hstep, voffB); PG8_STAGE(PG8_SA(0, 1), cA + hstep, voffA);
        if (wr == 1) PG8_BAR;
        PG8_WAIT_V(4); PG8_BAR;
        PG8_STAGE(PG8_SB(1, 0), cB + kstep, voffB); PG8_STAGE(PG8_SA(1, 0), cA + kstep, voffA); PG8_STAGE(PG8_SB(1, 1), cB + hstep + kstep, voffB);
        PG8_WAIT_V(6); PG8_BAR;
    }
    for (;;) {
        const bool has_next = S.next(ui + 1, nxt);
        const char* nA = (has_next && !GATHER) ? (const char*)g.A + (size_t)nxt.pm * tstep : cA; const char* nB = has_next ? (const char*)g.Bt + (size_t)nxt.pn * tstep : cB;
        if constexpr (GATHER) { if (has_next) { PG8_GIDX(vAn, nxt.pm); } else {
#pragma unroll
            for (int _h = 0; _h < 2; ++_h) { vAn[_h][0] = vAc[_h][0]; vAn[_h][1] = vAc[_h][1]; } } }
        for (int t = 0; t < nt; t += 2) {
            const bool last = (t == nt - 2);
            const char* a1 = cA + (size_t)(t + 1) * kstep;
            const char* a2 = last ? nA : cA + (size_t)(t + 2) * kstep; const char* b2 = last ? nB : cB + (size_t)(t + 2) * kstep;
            const char* a3 = a2 + kstep; const char* b3 = b2 + kstep;
            if (last && has_next) S.a_ready(nxt);
            if constexpr (GATHER) {
#pragma unroll
                for (int _h = 0; _h < 2; ++_h) { vA2[_h][0] = last ? vAn[_h][0] : vAc[_h][0]; vA2[_h][1] = last ? vAn[_h][1] : vAc[_h][1]; } }
            if constexpr (Epi::MIDSCALE) { if (t == nt / 2) E.midscale(acc, cur, ui, wr, fr); }
            if constexpr (SP2) {
            PG8_LDB(B0, 0, 0); PG8_LDB(B1, 0, 1); PG8_SCHED; PG8_LDA(At, 0, 0); PG8_STAGEA(PG8_SA(1, 1), a1, 1, vAc);
            PG8_WAIT_V(8); PG8_WAIT_L(0); PG8_BAR; PG8_MMA(0, 0, At, B0); PG8_MMA(0, 1, At, B1); PG8_BAR; PG8_SCHED;
            PG8_LDA(At, 0, 1); PG8_STAGE(PG8_SB(0, 0), b2, voffB); PG8_STAGE(PG8_SB(0, 1), b2 + hstep, voffB); PG8_STAGEA(PG8_SA(0, 0), a2, 0, vA2);
            PG8_WAIT_V(8); PG8_WAIT_L(0); PG8_BAR; PG8_MMA(1, 0, At, B0); PG8_MMA(1, 1, At, B1); PG8_BAR; PG8_SCHED;
            PG8_LDB(B0, 1, 0); PG8_LDB(B1, 1, 1); PG8_SCHED; PG8_LDA(At, 1, 0); PG8_STAGEA(PG8_SA(0, 1), a2, 1, vA2);
            PG8_WAIT_V(8); PG8_WAIT_L(0); PG8_BAR; PG8_MMA(0, 0, At, B0); PG8_MMA(0, 1, At, B1); PG8_BAR; PG8_SCHED;
            PG8_LDA(At, 1, 1); PG8_STAGE(PG8_SB(1, 0), b3, voffB); PG8_STAGE(PG8_SB(1, 1), b3 + hstep, voffB); PG8_STAGEA(PG8_SA(1, 0), a3, 0, vA2);
            PG8_WAIT_V(8); PG8_WAIT_L(0); PG8_BAR; PG8_MMA(1, 0, At, B0); PG8_MMA(1, 1, At, B1); PG8_BAR; PG8_SCHED;
            } else {
            PG8_LDB(B0, 0, 0); PG8_SCHED; PG8_LDA(At, 0, 0); PG8_STAGE(PG8_SA(1, 1), a1 + hstep, voffA);
            PG8_WAIT_L(8); PG8_BAR; PG8_WAIT_L(0); PG8_MMA(0, 0, At, B0); PG8_BAR; PG8_SCHED;
            PG8_LDB(B1, 0, 1); PG8_STAGE(PG8_SB(0, 0), b2, voffB);
            PG8_BAR; PG8_WAIT_L(0); PG8_MMA(0, 1, At, B1); PG8_BAR;
            PG8_LDA(At, 0, 1); PG8_STAGE(PG8_SA(0, 0), a2, voffA);
            PG8_BAR; PG8_WAIT_L(0); PG8_MMA(1, 0, At, B0); PG8_BAR; PG8_SCHED;
            PG8_STAGE(PG8_SB(0, 1), b2 + hstep, voffB);
            PG8_WAIT_V(6); PG8_BAR; PG8_MMA(1, 1, At, B1); PG8_BAR;
            PG8_LDB(B0, 1, 0); PG8_SCHED; PG8_LDA(At, 1, 0); PG8_STAGE(PG8_SA(0, 1), a2 + hstep, voffA);
            PG8_WAIT_L(8); PG8_BAR; PG8_WAIT_L(0); PG8_MMA(0, 0, At, B0); PG8_BAR; PG8_SCHED;
            PG8_LDB(B1, 1, 1); PG8_STAGE(PG8_SB(1, 0), b3, voffB);
            PG8_BAR; PG8_WAIT_L(0); PG8_MMA(0, 1, At, B1); PG8_BAR;
            PG8_LDA(At, 1, 1); PG8_STAGE(PG8_SA(1, 0), a3, voffA);
            PG8_BAR; PG8_WAIT_L(0); PG8_MMA(1, 0, At, B0); PG8_BAR; PG8_SCHED;
            PG8_STAGE(PG8_SB(1, 1), b3 + hstep, voffB);
            PG8_WAIT_V(6); PG8_BAR; PG8_MMA(1, 1, At, B1); PG8_BAR;
            }
        }
        if constexpr (ALIGN_EPI) { if (wr == 0) PG8_BAR; }
        if constexpr (F8) asm volatile("s_nop 15\n\ts_nop 7" ::: "memory");
        if constexpr (HOST) {
            E.part(acc, cur, wr, wc, fr, fq, 0);
            PG8_SCHED;
            ::f32x4 hr[8]; const int hit0 = hw.first + ui * hw.stride; const bool hhave = hit0 < hw.last; const int hit = hhave ? hit0 : hw.first;
            const TItem HI = wdown_item(*hw.a, hit); titem8_load(HI, hr, lane);
            PG8_SCHED;
            E.part(acc, cur, wr, wc, fr, fq, 1); S.done(cur);
            PG8_SCHED;
            titem8_store(titem8_outptr(HI, lane), hr, hw.scr, lane, hhave);
        } else
        if constexpr (!Epi::AFTER_DRAIN) { if constexpr (Epi::MIDSCALE) E.finish(acc, cur, ui, wr, wc, fr, fq); else E(acc, cur, wr, wc, fr, fq); S.done(cur); }
        if (!has_next) break;
#pragma unroll
        for (int a = 0; a < 2; ++a)
#pragma unroll
            for (int b = 0; b < 2; ++b)
#pragma unroll
                for (int m = 0; m < 4; ++m)
#pragma unroll
                    for (int n = 0; n < 2; ++n) acc[a][b][m][n] = (f32x4){0.f, 0.f, 0.f, 0.f};
        cur = nxt; cA = nA; cB = nB; ++ui;
        if constexpr (GATHER) {
#pragma unroll
            for (int _h = 0; _h < 2; ++_h) { vAc[_h][0] = vAn[_h][0]; vAc[_h][1] = vAn[_h][1]; } }
        if constexpr (Epi::MIDSCALE) E.unit_begin(cur, ui, tid);
        if constexpr (ALIGN_EPI) { if (wr == 1) PG8_BAR; }
    }
    PG8_WAIT_V(0);
    if constexpr (!ALIGN_EPI) { if (wr == 0) PG8_BAR; }
    PG8_BAR;
    if constexpr (Epi::AFTER_DRAIN) { E.fused(acc, cur, wr, wc, fr, fq, lds, wid, lane); S.done(cur); }
#undef PG8_SA
#undef PG8_SB
#undef PG8_STAGE
#undef PG8_STAGEA
#undef PG8_GIDX
#undef PG8_LDA
#undef PG8_LDB
#undef PG8_MMA
#undef PG8_CAT8
#undef PG8_WAIT_V
#undef PG8_WAIT_L
#undef PG8_BAR
#undef PG8_SCHED
}
}
namespace pg8 {
struct GroupedOrder {
    int nwg, npn, pn_grouped, G, c, nextra;
    __device__ __forceinline__ void init(int nwg_, int npn_, int pn_grouped_, int G_, int c_, int nextra_) { nwg = nwg_; npn = npn_; pn_grouped = pn_grouped_; G = G_; c = c_; nextra = nextra_; }
    __device__ __forceinline__ bool next(int i, Unit& u) const {
        const int L = i * G + c; if (L >= nwg + nextra) return false;
        if (L >= nwg) { const int x = L - nwg; u.pm = 64 + (x >> 2); u.pn = 2 + (x & 3); return true; }
        int wgid = L; { const int q = nwg / NXCD, r = nwg % NXCD, xcd = wgid % NXCD, off = wgid / NXCD; wgid = (xcd < r ? xcd * (q + 1) : r * (q + 1) + (xcd - r) * q) + off; }
        const int upg = 8 * npn, grp = wgid / upg, loc = wgid % upg;
        u.pm = grp * 8 + (loc & 7); u.pn = (pn_grouped ? grp * npn : 0) + (loc >> 3); return true;
    }
    __device__ __forceinline__ void a_ready(const Unit&) const {}
    __device__ __forceinline__ void done(const Unit&) const {}
};
__device__ __forceinline__ unsigned cvt_pk_bf16(float lo, float hi) { return ::cvtpk(lo, hi); }
__device__ __forceinline__ float gelu_fast(float x) { const float u = (-1.5957691216057308f * LOG2E) * (x + 0.044715f * x * x * x); return x * __builtin_amdgcn_rcpf(1.f + __builtin_amdgcn_exp2f(u)); }
__device__ __forceinline__ float silu_fast(float x) { return x * __builtin_amdgcn_rcpf(1.f + __builtin_amdgcn_exp2f(-LOG2E * x)); }

struct EpiInproj {
    static constexpr bool PERM = true, AFTER_DRAIN = false, MIDSCALE = false;
    bf16_t* Z; bf16_t* KVC;
    __device__ __forceinline__ void operator()(const f32x4 (&acc)[2][2][4][2], const Unit& u, int wr, int wc, int fr, int fq) const {
        const bool isctx = u.pm >= 64, act = (!isctx) && u.pn >= 6;
        bf16_t* base = isctx ? KVC : Z; const int ldc = isctx ? DM : DIN;
        const int row0 = (isctx ? (u.pm - 64) : u.pm) * BM + wr * 64 + fr, col0 = (isctx ? (u.pn - 2) : u.pn) * BM + wc * 32 + 8 * fq;
#pragma unroll
        for (int ai = 0; ai < 2; ++ai)
#pragma unroll
            for (int m = 0; m < 4; ++m) { bf16_t* rowp = base + (size_t)(row0 + ai * HALF + m * 16) * ldc + col0;
#pragma unroll
                for (int bj = 0; bj < 2; ++bj) { f32x4 v0 = acc[ai][bj][m][0], v1 = acc[ai][bj][m][1];
                    if (act) { v0 = (f32x4){gelu_fast(v0[0]), gelu_fast(v0[1]), gelu_fast(v0[2]), gelu_fast(v0[3])}; v1 = (f32x4){gelu_fast(v1[0]), gelu_fast(v1[1]), gelu_fast(v1[2]), gelu_fast(v1[3])}; }
                    u32x4 w; w.x = cvt_pk_bf16(v0[0], v0[1]); w.y = cvt_pk_bf16(v0[2], v0[3]); w.z = cvt_pk_bf16(v1[0], v1[1]); w.w = cvt_pk_bf16(v1[2], v1[3]);
                    *(u32x4*)(rowp + bj * HALF) = w; } }
    }
};
struct EpiOutproj {
    static constexpr bool PERM = false, AFTER_DRAIN = false, MIDSCALE = true;
    const float* x; bf16_t* out; const float* MOD; const float* SS; PG8_LAS float* tab;
    __device__ __forceinline__ void unit_begin(const Unit& u, int ui, int tid) const {
        if (tid < BM) { const f32x2 ss = *(const f32x2*)(SS + (size_t)(u.pm * BM + tid) * 2);
            const float ra = rsqrtf(ss.x * (1.f / 512.f) + EPS), rb = rsqrtf(ss.y * (1.f / 512.f) + EPS);
            PG8_LAS float* t = tab + ((ui & 1) * BM + tid) * 2; t[0] = ra / rb; t[1] = rb; }
    }
    __device__ __forceinline__ void midscale(f32x4 (&acc)[2][2][4][2], const Unit& u, int ui, int wr, int fr) const {
#pragma unroll
        for (int ai = 0; ai < 2; ++ai)
#pragma unroll
            for (int m = 0; m < 4; ++m) { const float r = tab[((ui & 1) * BM + ai * HALF + wr * 64 + m * 16 + fr) * 2];
#pragma unroll
                for (int bj = 0; bj < 2; ++bj)
#pragma unroll
                    for (int n = 0; n < 2; ++n) acc[ai][bj][m][n] = acc[ai][bj][m][n] * r; }
    }
    __device__ __forceinline__ void finish(const f32x4 (&acc)[2][2][4][2], const Unit& u, int ui, int wr, int wc, int fr, int fq) const {
        const int b = u.pm >> 3, col0 = u.pn * BM + wc * 32 + 4 * fq;
        f32x4 g1[2][2];
#pragma unroll
        for (int bj = 0; bj < 2; ++bj)
#pragma unroll
            for (int n = 0; n < 2; ++n) g1[bj][n] = *(const f32x4*)(MOD + b * NMOD + 2 * DM + col0 + bj * HALF + n * 16);
#pragma unroll
        for (int ai = 0; ai < 2; ++ai)
#pragma unroll
            for (int m = 0; m < 4; ++m) { const int r = ai * HALF + wr * 64 + m * 16 + fr; const float rb = tab[((ui & 1) * BM + r) * 2 + 1];
                const size_t off = (size_t)(u.pm * BM + r) * DM + col0;
#pragma unroll
                for (int bj = 0; bj < 2; ++bj)
#pragma unroll
                    for (int n = 0; n < 2; ++n) { const f32x4 xv = *(const f32x4*)(x + off + bj * HALF + n * 16); const f32x4 r = xv + g1[bj][n] * (acc[ai][bj][m][n] * rb); u32x2 w; w.x = cvt_pk_bf16(r[0], r[1]); w.y = cvt_pk_bf16(r[2], r[3]); *(u32x2*)(out + off + bj * HALF + n * 16) = w; } }
    }
};
struct EpiMoe1 {
    static constexpr bool PERM = true, AFTER_DRAIN = false, MIDSCALE = false;
    unsigned char* ACT;
    __device__ __forceinline__ void operator()(const f32x4 (&acc)[2][2][4][2], const Unit& u, int wr, int wc, int fr, int fq) const { part(acc, u, wr, wc, fr, fq, 0); part(acc, u, wr, wc, fr, fq, 1); }
    __device__ __forceinline__ void part(const f32x4 (&acc)[2][2][4][2], const Unit& u, int wr, int wc, int fr, int fq, const int ai) const {
        const int f0 = (u.pn % 12) * HALF + wc * 32 + 8 * fq;
        constexpr float SI = 1.f / (A8_SCALE * W8_SCALE);
        {
#pragma unroll
            for (int m = 0; m < 4; ++m) { unsigned char* rowp = ACT + (size_t)(u.pm * BM + ai * HALF + wr * 64 + m * 16 + fr) * DE + f0;
                const f32x4 g0 = acc[ai][0][m][0] * SI, g1 = acc[ai][0][m][1] * SI, u0 = acc[ai][1][m][0] * (SI * A8_SCALE), u1 = acc[ai][1][m][1] * (SI * A8_SCALE);
                u32x2 w; w.x = cvt4_fp8(silu_fast(g0[0]) * u0[0], silu_fast(g0[1]) * u0[1], silu_fast(g0[2]) * u0[2], silu_fast(g0[3]) * u0[3]);
                w.y = cvt4_fp8(silu_fast(g1[0]) * u1[0], silu_fast(g1[1]) * u1[1], silu_fast(g1[2]) * u1[2], silu_fast(g1[3]) * u1[3]);
                *(u32x2*)rowp = w; }
        }
    }
};
struct EpiMoe2 {
    static constexpr bool PERM = true, AFTER_DRAIN = false, MIDSCALE = false;
    unsigned char* Y; const float* GATE;
    __device__ __forceinline__ void operator()(const f32x4 (&acc)[2][2][4][2], const Unit& u, int wr, int wc, int fr, int fq) const {
        const int col0 = (u.pn & 3) * BM + wc * 32 + 8 * fq;
        const float* gp = GATE + ((u.pm & 7) * NE + (u.pm >> 3)) * CAP + wr * 64 + fr;
#pragma unroll
        for (int ai = 0; ai < 2; ++ai)
#pragma unroll
            for (int m = 0; m < 4; ++m) { const float gt = gp[ai * HALF + m * 16] * (Y8_SCALE / (A8_SCALE * W8_SCALE));
                unsigned char* rowp = Y + (size_t)(u.pm * BM + ai * HALF + wr * 64 + m * 16 + fr) * DM + col0;
#pragma unroll
                for (int bj = 0; bj < 2; ++bj) { const f32x4 v0 = acc[ai][bj][m][0] * gt, v1 = acc[ai][bj][m][1] * gt;
                    u32x2 w; w.x = cvt4_fp8(v0[0], v0[1], v0[2], v0[3]); w.y = cvt4_fp8(v1[0], v1[1], v1[2], v1[3]);
                    *(u32x2*)(rowp + bj * HALF) = w; } }
    }
};
}

#define LAS3 __attribute__((address_space(3)))
constexpr int RING_BYTES_C = 131072, LDS_TOP_C = 147456;
__device__ __forceinline__ void phase_inproj(const Args& a, LAS3 unsigned char* lds) {
    const int G = gridDim.x;
    const int wave = __builtin_amdgcn_readfirstlane(threadIdx.x >> 6), lane = threadIdx.x & 63;
    pg8::Gemm g{(const bf16_t*)(a.ws + WS_H), (const bf16_t*)(a.ws + WS_WIN), NTOK + NCTX, DIN, DM, nullptr};
    pg8::GroupedOrder S; S.init((NTOK / 256) * (DIN / 256), DIN / 256, 0, G, blockIdx.x, (NCTX / 256) * 4);
    pg8::EpiInproj E{(bf16_t*)(a.ws + WS_Z), (bf16_t*)(a.ws + WS_KVC)};
    pg8::gemm_phase<pg8::EpiInproj, pg8::GroupedOrder, true, true>(lds, g, S, E);
    const int nun = (NTOK / 256) * (DIN / 256) + (NCTX / 256) * 4, rounds = (nun + G - 1) / G, first_idle = nun - (rounds - 1) * G;
    const unsigned scr = (unsigned)(size_t)lds + wave * 4096;
    if (first_idle + 32 <= G) { if ((int)blockIdx.x >= first_idle) wconv_stream4(a, scr, WI_MIX_END + ((int)blockIdx.x - first_idle) * 8 + wave, WI_DENSE + WI_MOE, (G - first_idle) * 8, lane); }
    else wconv_range<false>(a, scr, WI_MIX_END + (int)blockIdx.x * 8 + wave, WI_DENSE + WI_MOE, G * 8, lane);
}
__device__ __forceinline__ void phase_outproj(const Args& a, LAS3 unsigned char* lds) {
    pg8::Gemm g{(const bf16_t*)(a.ws + WS_OPRE), (const bf16_t*)(a.ws + WS_WOUT), NTOK, DM, DM, nullptr};
    pg8::GroupedOrder S; S.init((NTOK / 256) * (DM / 256), DM / 256, 0, gridDim.x, blockIdx.x, 0);
    pg8::EpiOutproj E{a.in[0], (bf16_t*)(a.ws + WS_XNB), (const float*)(a.ws + WS_MOD), (const float*)(a.ws + WS_SS), (LAS3 float*)(lds + 131072 + 1024)};
    pg8::gemm_phase<pg8::EpiOutproj, pg8::GroupedOrder, true, true>(lds, g, S, E);
}
__device__ __forceinline__ void phase_moe1(const Args& a, LAS3 unsigned char* lds) {
    pg8::Gemm g{(const bf16_t*)(a.ws + WS_H2), (const bf16_t*)(a.ws + WS_W1), NE * 2048, NE * 3072, DM / 2, (const int*)(a.ws + WS_IDX)};
    pg8::GroupedOrder S; S.init(NE * 8 * 12, 12, 1, gridDim.x, blockIdx.x, 0);
    pg8::EpiMoe1 E{a.ws + WS_ACT};
    pg8::gemm_phase<pg8::EpiMoe1, pg8::GroupedOrder, true, true, true, true>(lds, g, S, E);
}
__device__ __forceinline__ void phase_moe2(const Args& a, LAS3 unsigned char* lds) {
    pg8::Gemm g{(const bf16_t*)(a.ws + WS_ACT), (const bf16_t*)(a.ws + WS_W2), NE * 2048, NE * DM, DE / 2, nullptr};
    pg8::GroupedOrder S; S.init(NE * 8 * 4, 4, 1, gridDim.x, blockIdx.x, 0);
    pg8::EpiMoe2 E{a.ws + WS_Y, (const float*)(a.ws + WS_GATE)};
    pg8::gemm_phase<pg8::EpiMoe2, pg8::GroupedOrder, true, true, false, true>(lds, g, S, E);
}
namespace mix {
#define MLAS __attribute__((address_space(3)))
typedef short v4i16_t __attribute__((ext_vector_type(4)));
__device__ __forceinline__ void vtr2(v4i16_t& lo, v4i16_t& hi, unsigned addr) {
    asm volatile("ds_read_b64_tr_b16 %0, %2\n\tds_read_b64_tr_b16 %1, %2 offset:2048" : "=&v"(lo), "=&v"(hi) : "v"(addr) : "memory");
}
#define VTR_WAIT(N) do { asm volatile("s_waitcnt lgkmcnt(" #N ")" ::: "memory"); __builtin_amdgcn_sched_barrier(0); } while (0)
__device__ __forceinline__ unsigned lds_addr(const MLAS unsigned char* p) { return (unsigned)(size_t)p; }
__device__ __forceinline__ float max_g4(float v) {
    const auto r1 = __builtin_amdgcn_permlane16_swap(__float_as_uint(v), __float_as_uint(v), false, false); v = fmaxf(__uint_as_float(r1[0]), __uint_as_float(r1[1]));
    const auto r2 = __builtin_amdgcn_permlane32_swap(__float_as_uint(v), __float_as_uint(v), false, false); return fmaxf(__uint_as_float(r2[0]), __uint_as_float(r2[1]));
}
__device__ __forceinline__ float sum_g4(float v) {
    const auto r1 = __builtin_amdgcn_permlane16_swap(__float_as_uint(v), __float_as_uint(v), false, false); v = __uint_as_float(r1[0]) + __uint_as_float(r1[1]);
    const auto r2 = __builtin_amdgcn_permlane32_swap(__float_as_uint(v), __float_as_uint(v), false, false); return __uint_as_float(r2[0]) + __uint_as_float(r2[1]);
}
__device__ __forceinline__ int clampi(int v, int lo, int hi) { return v < lo ? lo : (v > hi ? hi : v); }
constexpr int NSLOT = 6, SLOTB = 16384;
constexpr int BIASB = 15 * 128 * 4;
constexpr int L_RING = 0, L_BIAS = NSLOT * SLOTB, L_STAT = L_BIAS + BIASB, L_WSCR = L_STAT + 2048, WSCRB = 4352, L_ZN = 0;
static_assert(L_WSCR + 8 * WSCRB <= 147456 - 512, "mixer LDS map");
constexpr float NEG = -1e30f;
#ifndef ATT_HOST_MAX_V
#define ATT_HOST_MAX_V 18
#endif
constexpr int ATT_HOST_MAX = ATT_HOST_MAX_V;
#define ATT_WAIT_BAR(N) asm volatile("s_waitcnt vmcnt(" #N ") lgkmcnt(0)\n\ts_barrier" ::: "memory")

struct AttnStream {
    int u0, nu, iu, it, us;
    int nrows; const bf16_t* rp;
};
__device__ __forceinline__ void unit_geom(int unit, int& b, int& h, int& r0, int& U0, int& nrows) {
    b = unit >> 7; h = (unit >> 4) & 7; r0 = (unit & 15) * 2; U0 = clampi(r0 - 4, 0, ROWS - 8); const int nwin = clampi(r0 - 3, 0, ROWS - 8) + 8 - U0; nrows = (nwin + 1) & ~1;
}
__device__ __forceinline__ void attn_seek(const Args& a, AttnStream& S, int wid, int lane) {
    const bf16_t* Z = (const bf16_t*)(a.ws + WS_Z); const bf16_t* KVC = (const bf16_t*)(a.ws + WS_KVC);
    int b, h, r0, U0, nrows; unit_geom(S.u0 + S.iu * S.us, b, h, r0, U0, nrows); S.nrows = nrows;
    const int row = 8 * wid + (lane >> 3);
    S.rp = (S.it < nrows) ? Z + (size_t)(b * SEQ + (U0 + S.it) * GW + row) * DIN + DNA + h * HD
                          : KVC + (size_t)(b * CTXL + (S.it - nrows) * 64 + row) * DM + h * HD;
}
__device__ __forceinline__ void attn_issue(const Args& a, MLAS unsigned char* lds, AttnStream& S, int slot, int wid, int lane) {
    const int ck = (lane & 7) ^ (lane >> 3);
    const int cv = ((((lane & 7) >> 1) ^ ((lane >> 4) & 3)) << 1) | (lane & 1);
    MLAS unsigned char* dst = lds + L_RING + slot * SLOTB + wid * 1024;
    __builtin_amdgcn_global_load_lds((const unsigned*)(S.rp + ck * 8), (MLAS unsigned*)dst, 16, 0, 0);
    __builtin_amdgcn_global_load_lds((const unsigned*)(S.rp + 512 + cv * 8), (MLAS unsigned*)(dst + 8192), 16, 0, 0);
    const int it1 = S.it + 1;
    if (it1 < S.nrows) { S.it = it1; S.rp += (size_t)GW * DIN; }
    else if (it1 > S.nrows && it1 < S.nrows + CTXL / 64) { S.it = it1; S.rp += (size_t)64 * DM; }
    else if (it1 == S.nrows) { S.it = it1; attn_seek(a, S, wid, lane); }
    else if (S.iu + 1 < S.nu) { ++S.iu; S.it = 0; attn_seek(a, S, wid, lane); }
}

template <bool WIN>
__device__ __forceinline__ void attn_step(const MLAS unsigned char* Kp0, const MLAS unsigned char* Kp1, bool use0, bool use1, const MLAS float* brow0, const MLAS float* brow1,
                                          const f32x4 (&negmask)[2], const bf16x8 qf0, const bf16x8 qf1, float& mrun, float& lrun, f32x4 (&O)[4], int koff0, int koff1, int voff, int vsw) {
    const unsigned va0 = lds_addr(Kp0 + 8192) + voff, va1 = lds_addr(Kp1 + 8192) + voff;
    v4i16_t x0[4], y0[4], x1[4], y1[4];
    if (use0) {
#pragma unroll
        for (int db = 0; db < 4; ++db) vtr2(x0[db], y0[db], va0 + ((db ^ vsw) << 5)); }
    if (use1) {
#pragma unroll
        for (int db = 0; db < 4; ++db) vtr2(x1[db], y1[db], va1 + ((db ^ vsw) << 5)); }
    f32x4 s[4];
#pragma unroll
    for (int pr = 0; pr < 2; ++pr) {
        const bool use = pr ? use1 : use0; const MLAS unsigned char* Kp = pr ? Kp1 : Kp0;
        if (use) {
#pragma unroll
            for (int kbi = 0; kbi < 2; ++kbi) {
                const bf16x8 a0 = *(const MLAS bf16x8*)(Kp + kbi * 2048 + koff0), a1 = *(const MLAS bf16x8*)(Kp + kbi * 2048 + koff1);
                const f32x4 c0 = WIN ? negmask[kbi] : (f32x4){0.f, 0.f, 0.f, 0.f};
                const f32x4 acc = __builtin_amdgcn_mfma_f32_16x16x32_bf16(a0, qf0, c0, 0, 0, 0);
                s[2 * pr + kbi] = __builtin_amdgcn_mfma_f32_16x16x32_bf16(a1, qf1, acc, 0, 0, 0);
            }
        } else { s[2 * pr] = (f32x4){NEG, NEG, NEG, NEG}; s[2 * pr + 1] = (f32x4){NEG, NEG, NEG, NEG}; }
    }
    if (WIN) {
        f32x4 bv[4];
#pragma unroll
        for (int pr = 0; pr < 2; ++pr) { const MLAS float* br = pr ? brow1 : brow0;
#pragma unroll
            for (int kbi = 0; kbi < 2; ++kbi)
#pragma unroll
                for (int j = 0; j < 4; ++j) bv[2 * pr + kbi][j] = br[kbi * 16 + j]; }
        asm volatile("" : "+v"(bv[0]), "+v"(bv[1]), "+v"(bv[2]), "+v"(bv[3]));
#pragma unroll
        for (int k = 0; k < 4; ++k) s[k] = s[k] + bv[k];
    }
    float mt = fmaxf(fmaxf(s[0][0], s[0][1]), fmaxf(s[0][2], s[0][3]));
#pragma unroll
    for (int k = 1; k < 4; ++k) mt = fmaxf(fmaxf(mt, fmaxf(s[k][0], s[k][1])), fmaxf(s[k][2], s[k][3]));
    mt = max_g4(mt);
    if (__any(mt > mrun + 8.f)) {
        const float mn = fmaxf(mrun, mt), alpha = __builtin_amdgcn_exp2f(mrun - mn); mrun = mn; lrun *= alpha;
#pragma unroll
        for (int db = 0; db < 4; ++db) O[db] = O[db] * alpha;
    }
#pragma unroll
    for (int k = 0; k < 4; ++k)
#pragma unroll
        for (int j = 0; j < 4; ++j) s[k][j] = __builtin_amdgcn_exp2f(s[k][j] - mrun);
    { const f32x4 t4 = (s[0] + s[1]) + (s[2] + s[3]); lrun += (t4[0] + t4[1]) + (t4[2] + t4[3]); }
    {
        u32x4 pw0, pw1;
        pw0.x = cvtpk(s[0][0], s[0][1]); pw0.y = cvtpk(s[0][2], s[0][3]); pw0.z = cvtpk(s[1][0], s[1][1]); pw0.w = cvtpk(s[1][2], s[1][3]);
        pw1.x = cvtpk(s[2][0], s[2][1]); pw1.y = cvtpk(s[2][2], s[2][3]); pw1.z = cvtpk(s[3][0], s[3][1]); pw1.w = cvtpk(s[3][2], s[3][3]);
        const bf16x8 pf0 = __builtin_bit_cast(bf16x8, pw0), pf1 = __builtin_bit_cast(bf16x8, pw1);
        if (use0) {
            VTR_WAIT(0);
#pragma unroll
            for (int db = 0; db < 4; ++db) { const bf16x8 af = (bf16x8){x0[db][0], x0[db][1], x0[db][2], x0[db][3], y0[db][0], y0[db][1], y0[db][2], y0[db][3]};
                O[db] = __builtin_amdgcn_mfma_f32_16x16x32_bf16(af, pf0, O[db], 0, 0, 0); }
        }
        if (use1) {
            VTR_WAIT(0);
#pragma unroll
            for (int db = 0; db < 4; ++db) { const bf16x8 af = (bf16x8){x1[db][0], x1[db][1], x1[db][2], x1[db][3], y1[db][0], y1[db][1], y1[db][2], y1[db][3]};
                O[db] = __builtin_amdgcn_mfma_f32_16x16x32_bf16(af, pf1, O[db], 0, 0, 0); }
        }
    }
}

__device__ __forceinline__ void attn_units(const Args& a, MLAS unsigned char* lds, int u0, int nu, int us, int& wit, bool accum) {
    const int tid = threadIdx.x, lane = tid & 63, wid = __builtin_amdgcn_readfirstlane(tid >> 6);
    const int q = lane & 15, g = lane >> 4;
    const bf16_t* Z = (const bf16_t*)(a.ws + WS_Z); bf16_t* OP = (bf16_t*)(a.ws + WS_OPRE);
    AttnStream S; S.u0 = u0; S.nu = nu; S.iu = 0; S.it = 0; S.us = us; attn_seek(a, S, wid, lane);
    int islot = 0, cslot = 0;
#pragma unroll
    for (int d = 0; d < NSLOT; ++d) { attn_issue(a, lds, S, islot, wid, lane); islot = (islot + 1 == NSLOT) ? 0 : islot + 1; }
    MLAS float* biasl = (MLAS float*)(lds + L_BIAS);
    const int koff0 = q * 128 + ((g ^ (q & 7)) << 4), koff1 = q * 128 + (((4 + g) ^ (q & 7)) << 4);
    const int q4 = q >> 2, p4 = q & 3, vrow = 4 * g + q4;
    const int vsw = (vrow >> 1) & 3, voff = vrow * 128 + (p4 & 1) * 8 + ((p4 >> 1) << 4);
    const int qg = wid & 3, qc = 16 * qg + q, cs = clampi(qc - 8, 0, GW - 16);
    const int kcs = (qg == 0) ? 0 : ((qg == 1) ? 8 : ((qg == 2) ? 24 : 32));
    f32x4 negmask[2];
#pragma unroll
    for (int kbi = 0; kbi < 2; ++kbi)
#pragma unroll
        for (int j = 0; j < 4; ++j) { const int kc = kcs + 16 * kbi + 4 * g + j; negmask[kbi][j] = (kc >= cs && kc < cs + 16) ? 0.f : NEG; }
    const int bidx0 = kcs + 4 * g - qc + 63;
    int hprev = -1, prev_n = 0;
    f32x4 wr_[8]; unsigned char* wop_ = nullptr; bool wfly = false; int wage = 0, whosted = 0, wstep = 0;
    const unsigned wscr = lds_addr(lds + L_WSCR + wid * WSCRB);
    const int wstride = (int)gridDim.x * 8, wlast = WI_MIX_END;
    int b, h, r0, U0, nrows; unit_geom(u0, b, h, r0, U0, nrows);
    bf16x8 qn0, qn1;
    { const bf16_t* qp = Z + (size_t)(b * SEQ + (r0 + (wid >> 2)) * GW + qc) * DIN + h * HD + 8 * g; qn0 = *(const bf16x8*)qp; qn1 = *(const bf16x8*)(qp + 32); }
    for (int iu = 0; iu < nu; ++iu) {
        unit_geom(u0 + iu * us, b, h, r0, U0, nrows);
        const int qrow = r0 + (wid >> 2), rsq = clampi(qrow - 4, 0, ROWS - 8);
        if (h != hprev) {
            if (hprev >= 0) ATT_WAIT_BAR(0);
            for (int i = tid; i < 15 * 128; i += 512) { const int rr = i >> 7, d = (i & 127) - 48; biasl[i] = (d >= 0 && d < 31) ? LOG2E * a.in[8][(h * 15 + rr) * 31 + d] : 0.f; }
            hprev = h;
        }
        const bf16x8 qf0 = qn0, qf1 = qn1;
        if (iu + 1 < nu) { int b2, h2, r2, U2, n2; unit_geom(u0 + (iu + 1) * us, b2, h2, r2, U2, n2);
            const bf16_t* qp = Z + (size_t)(b2 * SEQ + (r2 + (wid >> 2)) * GW + qc) * DIN + h2 * HD + 8 * g; qn0 = *(const bf16x8*)qp; qn1 = *(const bf16x8*)(qp + 32); }
        float mrun = NEG, lrun = 0.f;
        f32x4 O[4];
#pragma unroll
        for (int db = 0; db < 4; ++db) O[db] = (f32x4){0.f, 0.f, 0.f, 0.f};
        const int nsw = nrows >> 1, nst = nsw + CTXL / 64;
        for (int st = 0; st < nst; ++st) {
            if (wfly) { ATT_WAIT_BAR(12); ++wage; } else { ATT_WAIT_BAR(4); }
            if (wfly && wage == 2) { titem8_store(wop_, wr_, wscr, lane); wfly = false; }
            for (int k = 0; k < prev_n; ++k) { attn_issue(a, lds, S, islot, wid, lane); islot = (islot + 1 == NSLOT) ? 0 : islot + 1; }
            ++wstep;
            if (!wfly && wit < wlast && whosted < ATT_HOST_MAX && (wstep > 1 || (wid & 1) == 0)) { const TItem I = wconv_item(a, wit); titem8_load(I, wr_, lane); wop_ = titem8_outptr(I, lane); wit += wstride; wfly = true; wage = 0; ++whosted; }
            const MLAS unsigned char* sl0 = lds + L_RING + cslot * SLOTB;
            if (st < nsw) {
                const int c1 = (cslot + 1 == NSLOT) ? 0 : cslot + 1; const MLAS unsigned char* sl1 = lds + L_RING + c1 * SLOTB;
                const int krA = U0 + 2 * st, krB = krA + 1;
                const bool uA = (krA >= rsq) && (krA < rsq + 8), uB = (krB >= rsq) && (krB < rsq + 8);
                if (uA || uB)
                    attn_step<true>(sl0 + kcs * 128, sl1 + kcs * 128, uA, uB, biasl + clampi(krA - qrow + 7, 0, 14) * 128 + bidx0, biasl + clampi(krB - qrow + 7, 0, 14) * 128 + bidx0, negmask, qf0, qf1, mrun, lrun, O, koff0, koff1, voff, vsw);
                cslot = (c1 + 1 == NSLOT) ? 0 : c1 + 1; prev_n = 2;
            } else {
                attn_step<false>(sl0, sl0 + 32 * 128, true, true, biasl, biasl, negmask, qf0, qf1, mrun, lrun, O, koff0, koff1, voff, vsw);
                cslot = (cslot + 1 == NSLOT) ? 0 : cslot + 1; prev_n = 1;
            }
        }
        const float l = sum_g4(lrun);
        const float inv = 1.f / l;
        bf16_t* op = OP + (size_t)(b * SEQ + qrow * GW + qc) * DM + h * HD + 4 * g;
        float ssq = 0.f;
#pragma unroll
        for (int db = 0; db < 4; ++db) { const f32x4 o = O[db] * inv; u32x2 w; w.x = cvtpk(o[0], o[1]); w.y = cvtpk(o[2], o[3]); *(u32x2*)(op + db * 16) = w; ssq += (o[0] * o[0] + o[1] * o[1]) + (o[2] * o[2] + o[3] * o[3]); }
        ssq = sum_g4(ssq);
        if (g == 0 && accum) atomicAdd((float*)(a.ws + WS_SS) + (size_t)(b * SEQ + qrow * GW + qc) * 2, ssq);
    }
    if (wfly) titem8_store(wop_, wr_, wscr, lane);
    ATT_WAIT_BAR(0);
}

__device__ __forceinline__ void gmlp_unit(const Args& a, MLAS unsigned char* lds, int unit, bool accum, int& wit) {
    const int tid = threadIdx.x, lane = tid & 63, wid = __builtin_amdgcn_readfirstlane(tid >> 6);
    const int q = lane & 15, g = lane >> 4;
    const bf16_t* Z = (const bf16_t*)(a.ws + WS_Z); bf16_t* OP = (bf16_t*)(a.ws + WS_OPRE);
    const int half = unit & 1, c = (unit >> 1) & 15, b = unit >> 5;
    const int row0 = b * SEQ + c * 128;
    MLAS float* st = (MLAS float*)(lds + L_STAT);
    const int srow = tid >> 3, sch = tid & 7;
    const int prow = row0 + wid * 16 + q;
    u32x4 zs[16], zt[4][2];
#pragma unroll
    for (int rr = 0; rr < 16; ++rr) zs[rr] = *((const u32x4*)(Z + (size_t)(row0 + wid * 16 + rr) * DIN + 2048) + lane);
    bf16x8 bfr[4][4]; f32x4 gn[4][2]; u32x2 uw[4][4]; float bsv[4];
#define GMLP_LOAD_EARLY(gi_) do { const int ch0_ = (half * 4 + (gi_)) * 64; \
        gn[gi_][0] = *(const f32x4*)(a.in[11] + ch0_ + sch * 8); gn[gi_][1] = *(const f32x4*)(a.in[11] + ch0_ + sch * 8 + 4); \
        _Pragma("unroll") for (int hh = 0; hh < 2; ++hh) zt[gi_][hh] = *(const u32x4*)(Z + (size_t)(row0 + srow + 64 * hh) * DIN + 2048 + ch0_ + sch * 8); } while (0)
#define GMLP_LOAD_LATE(gi_) do { const int g8_ = half * 4 + (gi_), ch0_ = g8_ * 64; \
        const float* wrow_ = a.in[9] + (size_t)(g8_ * 128 + wid * 16 + q) * 128 + 4 * g; \
        _Pragma("unroll") for (int ks = 0; ks < 4; ++ks) { const f32x4 w0 = *(const f32x4*)(wrow_ + ks * 32), w1 = *(const f32x4*)(wrow_ + ks * 32 + 16); \
            u32x4 pw; pw.x = cvtpk(w0[0], w0[1]); pw.y = cvtpk(w0[2], w0[3]); pw.z = cvtpk(w1[0], w1[1]); pw.w = cvtpk(w1[2], w1[3]); bfr[gi_][ks] = __builtin_bit_cast(bf16x8, pw); } \
        _Pragma("unroll") for (int db = 0; db < 4; ++db) uw[gi_][db] = *(const u32x2*)(Z + (size_t)prow * DIN + 1536 + ch0_ + db * 16 + 4 * g); \
        bsv[gi_] = a.in[10][g8_ * 128 + wid * 16 + q]; } while (0)
    GMLP_LOAD_EARLY(0);
#pragma unroll
    for (int rr = 0; rr < 16; ++rr) {
        const u32x4 w = zs[rr];
        const float v[8] = {bflo(w.x), bfhi(w.x), bflo(w.y), bfhi(w.y), bflo(w.z), bfhi(w.z), bflo(w.w), bfhi(w.w)};
        float s = 0.f, s2 = 0.f;
#pragma unroll
        for (int i = 0; i < 8; ++i) { s += v[i]; s2 += v[i] * v[i]; }
#pragma unroll
        for (int o = 1; o < 64; o <<= 1) { s += __shfl_xor(s, o); s2 += __shfl_xor(s2, o); }
        const float mean = s * (1.f / DSG), var = fmaxf(s2 * (1.f / DSG) - mean * mean, 0.f);
        if (lane == 0) { st[(wid * 16 + rr) * 2] = mean; st[(wid * 16 + rr) * 2 + 1] = rsqrtf(var + EPS); }
    }
    LDS_BARRIER();
    const int q4 = q >> 2, p4 = q & 3;
    const int vrow = 4 * g + q4, vsw = (vrow >> 1) & 3, voff = vrow * 128 + (p4 & 1) * 8 + ((p4 >> 1) << 4);
    float ssq = 0.f;
#pragma unroll
    for (int gi = 0; gi < 4; ++gi) {
        const int g8 = half * 4 + gi, ch0 = g8 * 64;
        MLAS unsigned char* zb = lds + L_ZN + (gi & 1) * 16384;
        f32x4 wr_[8]; const int wmine = wit; const bool whave = accum && (wit < WI_MIX_END);
        unsigned char* wop_ = nullptr;
        if (whave) { const TItem I = wconv_item(a, wmine); titem8_load(I, wr_, lane); wop_ = titem8_outptr(I, lane); wit += (int)gridDim.x * 8; }
        GMLP_LOAD_LATE(gi);
        if (gi + 1 < 4) GMLP_LOAD_EARLY(gi + 1);
#pragma unroll
        for (int hh = 0; hh < 2; ++hh) {
            const int r = srow + 64 * hh;
            const u32x4 w = zt[gi][hh];
            const float mean = st[r * 2], rstd = st[r * 2 + 1];
            const f32x4 gn0 = gn[gi][0] * rstd, gn1 = gn[gi][1] * rstd;
            u32x4 o;
            o.x = cvtpk((bflo(w.x) - mean) * gn0[0], (bfhi(w.x) - mean) * gn0[1]); o.y = cvtpk((bflo(w.y) - mean) * gn0[2], (bfhi(w.y) - mean) * gn0[3]);
            o.z = cvtpk((bflo(w.z) - mean) * gn1[0], (bfhi(w.z) - mean) * gn1[1]); o.w = cvtpk((bflo(w.w) - mean) * gn1[2], (bfhi(w.w) - mean) * gn1[3]);
            *(MLAS u32x4*)(zb + r * 128 + (((((sch >> 1) ^ ((r >> 1) & 3)) << 1) | (sch & 1)) << 4)) = o;
        }
        LDS_BARRIER();
        f32x4 D[4];
#pragma unroll
        for (int db = 0; db < 4; ++db) D[db] = (f32x4){0.f, 0.f, 0.f, 0.f};
        const unsigned zba = lds_addr(zb) + voff;
#pragma unroll
        for (int kh = 0; kh < 2; ++kh) {
            v4i16_t x0[2][4], y0[2][4];
#pragma unroll
            for (int k2 = 0; k2 < 2; ++k2)
#pragma unroll
                for (int db = 0; db < 4; ++db) vtr2(x0[k2][db], y0[k2][db], zba + (2 * kh + k2) * 4096 + ((db ^ vsw) << 5));
#pragma unroll
            for (int k2 = 0; k2 < 2; ++k2) {
                if (k2 == 0) VTR_WAIT(8); else VTR_WAIT(0);
#pragma unroll
                for (int db = 0; db < 4; ++db) { const bf16x8 af = (bf16x8){x0[k2][db][0], x0[k2][db][1], x0[k2][db][2], x0[k2][db][3], y0[k2][db][0], y0[k2][db][1], y0[k2][db][2], y0[k2][db][3]};
                    D[db] = __builtin_amdgcn_mfma_f32_16x16x32_bf16(af, bfr[gi][2 * kh + k2], D[db], 0, 0, 0); }
            }
        }
#pragma unroll
        for (int db = 0; db < 4; ++db) {
            const float o0 = bflo(uw[gi][db].x) * (D[db][0] + bsv[gi]), o1 = bfhi(uw[gi][db].x) * (D[db][1] + bsv[gi]), o2 = bflo(uw[gi][db].y) * (D[db][2] + bsv[gi]), o3 = bfhi(uw[gi][db].y) * (D[db][3] + bsv[gi]);
            u32x2 w; w.x = cvtpk(o0, o1); w.y = cvtpk(o2, o3); ssq += (o0 * o0 + o1 * o1) + (o2 * o2 + o3 * o3);
            *(u32x2*)(OP + (size_t)prow * DM + DNA + ch0 + db * 16 + 4 * g) = w;
        }
        if (whave) titem8_store(wop_, wr_, lds_addr(lds + L_WSCR + wid * WSCRB), lane);
    }
    ssq += __shfl_xor(ssq, 16); ssq += __shfl_xor(ssq, 32);
    if (g == 0 && accum) atomicAdd((float*)(a.ws + WS_SS) + (size_t)prow * 2 + 1, ssq);
    LDS_BARRIER();
#undef GMLP_LOAD_EARLY
#undef GMLP_LOAD_LATE
}

__device__ __forceinline__ void phase_mix(const Args& a, MLAS unsigned char* lds) {
    const int G = gridDim.x; const int vcu = (G % 8 == 0) ? ((int)blockIdx.x % 8) * (G / 8) + (int)blockIdx.x / 8 : (int)blockIdx.x;
    constexpr int NAU = NB * NH * (ROWS / 2), NGU = NB * (SEQ / 128) * 2;
    const int upc = (NAU + G - 1) / G;
    const int wave = __builtin_amdgcn_readfirstlane(threadIdx.x >> 6), lane = threadIdx.x & 63;
    int wit = WI_DENSE + (int)blockIdx.x * 8 + wave;
    if (upc == 4 && NAU == 4 * G) {
        const int u0 = (vcu >> 2) * 16 + (vcu & 3); attn_units(a, lds, u0, 4, 4, wit, true); if (REP_MASK_V & 0x10000u) attn_units(a, lds, u0, 4, 4, wit, false);
    } else { const int u0 = vcu * upc, nu = (u0 + upc <= NAU) ? upc : (NAU - u0); if (nu > 0) { attn_units(a, lds, u0, nu, 1, wit, true); if (REP_MASK_V & 0x10000u) attn_units(a, lds, u0, nu, 1, wit, false); } }
    for (int unit = vcu; unit < NGU; unit += G) { gmlp_unit(a, lds, unit, true, wit); if (REP_MASK_V & 0x20000u) gmlp_unit(a, lds, unit, false, wit); }
    wconv_range<false>(a, lds_addr(lds + L_WSCR + wave * WSCRB), wit, WI_MIX_END, G * 8, lane);
}
}
#define GAS __attribute__((address_space(1)))
#define LAS __attribute__((address_space(3)))
constexpr int NWAVES = 8;
constexpr int RING_BYTES = 131072;
constexpr int LDSCTL_OFF = 147456 - 512, MISC_OFF = LDSCTL_OFF + 320;
constexpr int LDS_BYTES = 147456;
constexpr size_t CTL_ZERO_BYTES = 1 * MiB;
constexpr int CW_BAR = 4096;

#define XB_TMO      128
#define XB_XCNT(j)  (256  + 64 * (j))
#define XB_XSUB(j)  (1280 + 64 * (j))
#define XB_XGEN(j)  (2304 + 64 * (j))
#define XB_TOP      3328
#define XB_TOPGEN   3392
#define XCD_BAR_WORDS 3456
#define XB_SPIN_CAP (1u << 18)

__device__ __forceinline__ unsigned xb_ld(unsigned* p)              { return __hip_atomic_load(p, __ATOMIC_RELAXED, __HIP_MEMORY_SCOPE_AGENT); }
__device__ __forceinline__ unsigned xb_add(unsigned* p, unsigned v) { return __hip_atomic_fetch_add(p, v, __ATOMIC_RELAXED, __HIP_MEMORY_SCOPE_AGENT); }
__device__ __forceinline__ unsigned xb_xcc_id() { return (unsigned)__builtin_amdgcn_s_getreg((3 << 11) | 20) & 0xFu; }
#define XB_SPIN(cond, bar) do { unsigned _sp = 0; while (cond) { __builtin_amdgcn_s_sleep(1); \
    if ((++_sp & 255u) == 0u) { if (xb_ld(&(bar)[XB_TMO])) break; if (_sp > XB_SPIN_CAP) { atomicAdd(&(bar)[XB_TMO], 1u); break; } } } } while (0)

struct XcdBarrier { unsigned* bar; unsigned x; volatile LAS unsigned* st; };

__device__ __forceinline__ XcdBarrier xcd_barrier_post(unsigned* bar, volatile LAS unsigned* st) {
    XcdBarrier b; b.bar = bar; b.x = xb_xcc_id(); b.st = st;
    if (threadIdx.x == 0) (void)xb_add(&bar[XB_XCNT(b.x)], 1u);
    return b;
}
__device__ __forceinline__ void xcd_barrier_complete(unsigned* bar, unsigned x, unsigned& nloc, unsigned& nx) {
    const unsigned G = gridDim.x * gridDim.y * gridDim.z;
    unsigned sum, cnt, mine, sp = 0u;
    for (;;) {
        sum = 0u; cnt = 0u; mine = 0u;
#pragma unroll
        for (unsigned j = 0; j < 16; ++j) { const unsigned c = xb_ld(&bar[XB_XCNT(j)]); sum += c; cnt += (c > 0u) ? 1u : 0u; mine = (j == x) ? c : mine; }
        if (sum == G) break;
        __builtin_amdgcn_s_sleep(1);
        if ((++sp & 255u) == 0u) { if (xb_ld(&bar[XB_TMO])) break; if (sp > XB_SPIN_CAP) { atomicAdd(&bar[XB_TMO], 1u); break; } }
    }
    nloc = mine > 0u ? mine : 1u; nx = cnt > 0u ? cnt : 1u;
}
__device__ __forceinline__ void xcd_barrier(const XcdBarrier& b) {
    asm volatile("s_waitcnt vmcnt(0)" ::: "memory");
    __syncthreads();
    if (threadIdx.x == 0) {
        unsigned* bar = b.bar;
        __builtin_amdgcn_s_waitcnt(0);
        unsigned nloc = b.st[0], nx = b.st[1];
        if (nloc == 0u) { xcd_barrier_complete(bar, b.x, nloc, nx); b.st[0] = nloc; b.st[1] = nx; }
        const unsigned old = xb_add(&bar[XB_XSUB(b.x)], 1u);
        const unsigned gen = old / nloc;
        if (old + 1u == (gen + 1u) * nloc) {
            __builtin_amdgcn_fence(__ATOMIC_RELEASE, "agent");
            asm volatile("s_waitcnt vmcnt(0)" ::: "memory");
            (void)xb_add(&bar[XB_TOP], 1u);
        }
        XB_SPIN(xb_ld(&bar[XB_TOP]) < (gen + 1u) * nx, bar);
        __builtin_amdgcn_fence(__ATOMIC_ACQUIRE, "agent");
        asm volatile("s_waitcnt vmcnt(0)" ::: "memory");
    }
    __syncthreads();
}

constexpr int NPHASE = 10;
constexpr unsigned REP_MASK = REP_MASK_V;
__global__ void __launch_bounds__(NWAVES * 64, 2) mk_fwd(Args a) {
    extern __shared__ __attribute__((aligned(16))) unsigned char lds_raw[];
    float* lds = (float*)lds_raw;
    LAS unsigned char* ldsl = (LAS unsigned char*)lds_raw;
    for (int u = threadIdx.x; u < 512 / 4; u += NWAVES * 64) ((LAS unsigned*)(ldsl + LDSCTL_OFF))[u] = 0u;
    __syncthreads();
    unsigned* ctl = (unsigned*)(a.ws + WS_CTL);
    XcdBarrier bar = xcd_barrier_post(ctl + CW_BAR, (volatile LAS unsigned*)(ldsl + MISC_OFF) + 8);
    const int lo = a.ph_lo, hi = a.ph_hi;
#define IN(k) (lo <= (k) && (k) < hi)
#define SEAM(k) do { if (IN(k) && IN((k) + 1)) xcd_barrier(bar); } while (0)
#define REP(k, body) do { if (IN(k)) { body; if ((REP_MASK >> (k)) & 1u) { xcd_barrier(bar); body; } } } while (0)
    REP(0, { phase_mod(a, lds); phase_wconv(a, lds); }); if (IN(0) && IN(1)) mod_pre_wait(a);
    REP(1, { phase_prenorm(a); }); SEAM(1);
    REP(2, { phase_inproj(a, ldsl); }); SEAM(2);
    REP(3, { mix::phase_mix(a, ldsl); }); SEAM(3);
    REP(4, { phase_outproj(a, ldsl); }); SEAM(4);
    if (gridDim.x == NTOK / 64) { if (IN(5)) phase_norm2_topk(a, lds); SEAM(5); }
    else { REP(5, { phase_norm2(a, lds); }); SEAM(5); REP(6, { phase_topk(a, lds); }); if (IN(6)) xcd_barrier(bar); }
    REP(7, { phase_moe1(a, ldsl); }); SEAM(7);
    REP(8, { phase_moe2(a, ldsl); }); SEAM(8);
    if (IN(9)) { if (REP_MASK & 0x200u) { phase_final(a, (float*)(a.ws + WS_ACT)); xcd_barrier(bar); } phase_final(a, a.out); }
#undef REP
#undef IN
#undef SEAM
}

extern "C" void kernel_launch(void* const* d_in, const int* in_sizes, int n_in, void* d_out, int out_size, void* d_ws, size_t ws_size, hipStream_t stream) {
    static int grid = 0;
    if (grid == 0) {
        if (n_in != 21 || out_size != NTOK * DM || ws_size < WS_END) { fprintf(stderr, "kernel_launch: unexpected shapes n_in %d out %d ws %zu\n", n_in, out_size, ws_size); grid = -1; return; }
        int dev = 0, cus = 0, per_cu = 0;
        if (hipGetDevice(&dev) != hipSuccess || hipDeviceGetAttribute(&cus, hipDeviceAttributeMultiprocessorCount, dev) != hipSuccess) { grid = -1; return; }
        if (hipFuncSetAttribute((const void*)mk_fwd, hipFuncAttributeMaxDynamicSharedMemorySize, LDS_BYTES) != hipSuccess) { fprintf(stderr, "kernel_launch: hipFuncSetAttribute failed\n"); grid = -1; return; }
        if (hipOccupancyMaxActiveBlocksPerMultiprocessor(&per_cu, (const void*)mk_fwd, NWAVES * 64, LDS_BYTES) != hipSuccess || per_cu < 1)
            fprintf(stderr, "kernel_launch: note: occupancy query reports %d workgroups per CU\n", per_cu);
        (void)hipGetLastError();
        grid = cus;
    }
    if (grid < 0) return;
    if (hipMemsetAsync((char*)d_ws + WS_CTL, 0, CTL_ZERO_BYTES, stream) != hipSuccess) return;
    Args a{};
    for (int i = 0; i < 21; ++i) a.in[i] = (const float*)d_in[i];
    a.out = (float*)d_out; a.ws = (unsigned char*)d_ws; a.ph_lo = 0; a.ph_hi = NPHASE;
    hipLaunchKernelGGL(mk_fwd, dim3(grid), dim3(NWAVES * 64), LDS_BYTES, stream, a);
}
```

```cpp
#include <hip/hip_runtime.h>
#include <cstdio>
#include <cstdint>
#ifndef REP_MASK_V
#define REP_MASK_V 0u
#endif

typedef unsigned short bf16_t;
typedef short bf16x8 __attribute__((ext_vector_type(8)));
typedef float f32x4 __attribute__((ext_vector_type(4)));
typedef float f32x2 __attribute__((ext_vector_type(2)));
typedef unsigned u32x4 __attribute__((ext_vector_type(4)));
typedef unsigned u32x2 __attribute__((ext_vector_type(2)));
typedef __bf16 bf16x2_t __attribute__((ext_vector_type(2)));

constexpr int NB = 8, SEQ = 2048, DM = 1024, NTOK = NB * SEQ, CTXL = 256, NCTX = NB * CTXL;
constexpr int GW = 64, ROWS = SEQ / GW;
constexpr int NH = 8, HD = 64, DNA = 512, DSG = 512, DIN = 2560;
constexpr int NE = 16, CAP = 256, DE = 1536, NMOD = 6 * DM;
constexpr float EPS = 1e-6f;
constexpr float LOG2E = 1.4426950408889634f;
constexpr float Y8_SCALE = 64.f;
constexpr float W8_SCALE = 128.f, A8_SCALE = 4.f;
constexpr float QSCALE = 0.125f * LOG2E;

constexpr size_t MiB = 1u << 20;
constexpr size_t WS_CTL = 0;
constexpr size_t WS_PCNT = 128 * 1024;
constexpr size_t WS_SS = 256 * 1024;
constexpr size_t WS_MOD = 1 * MiB;
constexpr size_t WS_AFF = 2 * MiB;
constexpr size_t WS_GATE = 3 * MiB;
constexpr size_t WS_IDX = 3 * MiB + 512 * 1024;
constexpr size_t WS_SEL = 4 * MiB;
constexpr size_t WS_WOUT = 5 * MiB;
constexpr size_t WS_WIN = 7 * MiB;
constexpr size_t WS_W2 = 12 * MiB;
constexpr size_t WS_W1 = 60 * MiB;
constexpr size_t WS_XNB = 108 * MiB;
constexpr size_t WS_ACT = 156 * MiB;
constexpr size_t WS_Z = 156 * MiB;
constexpr size_t WS_H2 = 252 * MiB;
constexpr size_t WS_Y = 252 * MiB;
constexpr size_t WS_H = 252 * MiB;
constexpr size_t WS_KVC = 288 * MiB;
constexpr size_t WS_OPRE = 252 * MiB;
constexpr size_t WS_END = 316 * MiB;

struct Args { const float* in[21]; float* out; unsigned char* ws; int ph_lo, ph_hi; };

__device__ __forceinline__ unsigned cvtpk(float lo, float hi) { f32x2 v = {lo, hi}; bf16x2_t b = __builtin_convertvector(v, bf16x2_t); return __builtin_bit_cast(unsigned, b); }
__device__ __forceinline__ bf16_t f2bf(float f) { return (bf16_t)(cvtpk(f, 0.f) & 0xffffu); }
__device__ __forceinline__ float bf2f(bf16_t b) { return __uint_as_float(((unsigned)b) << 16); }
__device__ __forceinline__ float bflo(unsigned w) { return __uint_as_float(w << 16); }
__device__ __forceinline__ float bfhi(unsigned w) { return __uint_as_float(w & 0xffff0000u); }
__device__ __forceinline__ float clamp8(float v) { return __builtin_fminf(__builtin_fmaxf(v, -448.f), 448.f); }
__device__ __forceinline__ unsigned cvt4_fp8(float a, float b, float c, float d) {
    int w = __builtin_amdgcn_cvt_pk_fp8_f32(clamp8(a), clamp8(b), 0, false); w = __builtin_amdgcn_cvt_pk_fp8_f32(clamp8(c), clamp8(d), w, true); return (unsigned)w;
}
#define LDS_BARRIER() asm volatile("s_waitcnt lgkmcnt(0)\n\ts_barrier" ::: "memory")
template <int CTRL> __device__ __forceinline__ float dpp_f(float v) { return __uint_as_float((unsigned)__builtin_amdgcn_update_dpp(0, (int)__float_as_uint(v), CTRL, 0xF, 0xF, true)); }
__device__ __forceinline__ float row16_sum(float v) {
    v += dpp_f<0xB1>(v); v += dpp_f<0x4E>(v); v += dpp_f<0x141>(v); v += dpp_f<0x140>(v); return v;
}
__device__ __forceinline__ float row16_max(float v) {
    v = fmaxf(v, dpp_f<0xB1>(v)); v = fmaxf(v, dpp_f<0x4E>(v)); v = fmaxf(v, dpp_f<0x141>(v)); v = fmaxf(v, dpp_f<0x140>(v)); return v;
}
__device__ __forceinline__ float rows4_sum(float v) {
    const auto r1 = __builtin_amdgcn_permlane16_swap(__float_as_uint(v), __float_as_uint(v), false, false); v = __uint_as_float(r1[0]) + __uint_as_float(r1[1]);
    const auto r2 = __builtin_amdgcn_permlane32_swap(__float_as_uint(v), __float_as_uint(v), false, false); return __uint_as_float(r2[0]) + __uint_as_float(r2[1]);
}
__device__ __forceinline__ float wave_sum(float v) { return rows4_sum(row16_sum(v)); }
__device__ __forceinline__ float wave_max(float v) {
#pragma unroll
    for (int o = 1; o < 64; o <<= 1) v = fmaxf(v, __shfl_xor(v, o));
    return v;
}
__device__ __forceinline__ float silu_f(float x) { return x / (1.f + __expf(-x)); }
__device__ __forceinline__ float gelu_tanh(float x) {
    const float u = 1.5957691216057308f * (x + 0.044715f * x * x * x);
    return x / (1.f + __expf(-u));
}

constexpr int MOD_PRE_ITEMS = 2 * DM / 32;
__device__ __forceinline__ void phase_mod(const Args& a, float* lds) {
    const float* c = a.in[1]; const float* cc = a.in[3]; const float* wm = a.in[4]; const float* bm = a.in[5];
    float* MOD = (float*)(a.ws + WS_MOD);
    float* s = lds;
    float* red = lds + 1024 * 12;
    const int t = threadIdx.x;
    const int item0 = blockIdx.x; const bool has = item0 < NMOD / 32;
    const int col = item0 * 32 + (t & 31), kg = t >> 5;
    float w[64];
    if (has) { const float* wp = wm + (size_t)(kg * 64) * NMOD + col;
#pragma unroll
        for (int k = 0; k < 64; ++k) w[k] = __builtin_nontemporal_load(wp + (size_t)k * NMOD); }
    for (int i = t; i < 9 * 1024; i += 512) { const int r = i >> 10, k = i & 1023; const float v = (r < 8) ? c[i] : cc[k]; s[k * 12 + r] = silu_f(v); }
    __syncthreads();
    for (int item = item0; item < NMOD / 32; item += gridDim.x) {
        if (item != item0) { const float* wp = wm + (size_t)(kg * 64) * NMOD + item * 32 + (t & 31);
#pragma unroll
            for (int k = 0; k < 64; ++k) w[k] = __builtin_nontemporal_load(wp + (size_t)k * NMOD); }
        float acc[9];
#pragma unroll
        for (int r = 0; r < 9; ++r) acc[r] = 0.f;
#pragma unroll
        for (int k = 0; k < 64; ++k) {
            const float* sp = s + (kg * 64 + k) * 12; const f32x4 s0 = *(const f32x4*)sp, s1 = *(const f32x4*)(sp + 4); const float s8 = sp[8];
            acc[0] += s0.x * w[k]; acc[1] += s0.y * w[k]; acc[2] += s0.z * w[k]; acc[3] += s0.w * w[k];
            acc[4] += s1.x * w[k]; acc[5] += s1.y * w[k]; acc[6] += s1.z * w[k]; acc[7] += s1.w * w[k]; acc[8] += s8 * w[k];
        }
#pragma unroll
        for (int r = 0; r < 9; ++r) red[(kg * 9 + r) * 32 + (t & 31)] = acc[r];
        __syncthreads();
        if (t < 9 * 32) {
            const int r = t >> 5, cl = t & 31; float v = 0.f;
#pragma unroll
            for (int g = 0; g < 16; ++g) v += red[(g * 9 + r) * 32 + cl];
            __hip_atomic_store((unsigned*)MOD + r * NMOD + item * 32 + cl, __float_as_uint(v + bm[item * 32 + cl]), __ATOMIC_RELAXED, __HIP_MEMORY_SCOPE_AGENT);
        }
        __syncthreads();
        if (t == 0 && item < MOD_PRE_ITEMS) __hip_atomic_fetch_add((unsigned*)(a.ws + WS_PCNT) + 64 * 8, 1u, __ATOMIC_RELAXED, __HIP_MEMORY_SCOPE_AGENT);
    }
}
__device__ __forceinline__ void mod_pre_wait(const Args& a) {
    if (threadIdx.x == 0) {
        unsigned* cnt = (unsigned*)(a.ws + WS_PCNT) + 64 * 8; unsigned sp = 0;
        while (__hip_atomic_load(cnt, __ATOMIC_RELAXED, __HIP_MEMORY_SCOPE_AGENT) < (unsigned)MOD_PRE_ITEMS) { __builtin_amdgcn_s_sleep(1); if (++sp > (1u << 22)) break; }
        __builtin_amdgcn_fence(__ATOMIC_ACQUIRE, "agent");
        asm volatile("s_waitcnt vmcnt(0)" ::: "memory");
    }
    __syncthreads();
}

struct TItem { const float* W; int K, N, n0, k0, rowoff, gu; const float* kscale; float cs_lo; int cs_n; bf16_t* WT; };
typedef short wv4i16_t __attribute__((ext_vector_type(4)));
__device__ __forceinline__ void titem_load(const TItem& I, f32x4 (&r)[8], int lane) {
    const float* p = I.W + (size_t)(I.k0 + (lane >> 3)) * I.N + I.n0 + 4 * (lane & 7);
#pragma unroll
    for (int i = 0; i < 8; ++i) r[i] = __builtin_nontemporal_load((const f32x4*)(p + (size_t)(8 * i) * I.N));
}
template <bool KSC>
__device__ __forceinline__ void titem_store(const TItem& I, const f32x4 (&r)[8], unsigned scr, int lane) {
    float cs[4] = {1.f, 1.f, 1.f, 1.f};
    if (KSC) {
#pragma unroll
        for (int c = 0; c < 4; ++c) cs[c] = (I.n0 + 4 * (lane & 7) + c < I.cs_n) ? I.cs_lo : 1.f; }
#pragma unroll
    for (int i = 0; i < 8; ++i) {
        f32x4 v = r[i];
        if (KSC) { const float ks = I.kscale ? I.kscale[I.k0 + 8 * i + (lane >> 3)] : 1.f; v.x *= ks * cs[0]; v.y *= ks * cs[1]; v.z *= ks * cs[2]; v.w *= ks * cs[3]; }
        u32x2 w; w.x = cvtpk(v.x, v.y); w.y = cvtpk(v.z, v.w);
        asm volatile("ds_write_b64 %0, %1 offset:%c2" :: "v"(scr + lane * 8), "v"(w), "i"(i * 512) : "memory");
    }
    const int g = lane >> 4, li = lane & 15, c = g & 1;
    const unsigned ra = scr + ((li >> 2) * 64 + 32 * c + (li & 3) * 8) + (g >> 1) * 2048;
    wv4i16_t lo[4], hi[4];
    asm volatile("s_waitcnt lgkmcnt(0)" ::: "memory");
#pragma unroll
    for (int it = 0; it < 4; ++it)
        asm volatile("ds_read_b64_tr_b16 %0, %2 offset:%c3\n\tds_read_b64_tr_b16 %1, %2 offset:%c4" : "=&v"(lo[it]), "=&v"(hi[it]) : "v"(ra), "i"(it * 512), "i"(it * 512 + 256) : "memory");
    asm volatile("s_waitcnt lgkmcnt(0)" ::: "memory"); __builtin_amdgcn_sched_barrier(0);
    const int nn = I.n0 + 16 * c + li, orow = I.rowoff + (I.gu ? ((nn >> 7) * 256 + (nn & 127)) : nn);
    if (KSC) {
        bf16_t* op = I.WT + (size_t)orow * I.K + I.k0 + (g >> 1) * 32;
#pragma unroll
        for (int it = 0; it < 4; ++it) { const bf16x8 o = (bf16x8){lo[it][0], lo[it][1], lo[it][2], lo[it][3], hi[it][0], hi[it][1], hi[it][2], hi[it][3]}; *(bf16x8*)(op + 8 * it) = o; }
    } else {
        unsigned char* op = (unsigned char*)I.WT + (size_t)orow * I.K + I.k0 + (g >> 1) * 32;
#pragma unroll
        for (int it = 0; it < 4; ++it) {
            u32x2 o;
            o.x = cvt4_fp8(bf2f((bf16_t)lo[it][0]) * W8_SCALE, bf2f((bf16_t)lo[it][1]) * W8_SCALE, bf2f((bf16_t)lo[it][2]) * W8_SCALE, bf2f((bf16_t)lo[it][3]) * W8_SCALE);
            o.y = cvt4_fp8(bf2f((bf16_t)hi[it][0]) * W8_SCALE, bf2f((bf16_t)hi[it][1]) * W8_SCALE, bf2f((bf16_t)hi[it][2]) * W8_SCALE, bf2f((bf16_t)hi[it][3]) * W8_SCALE);
            *(u32x2*)(op + 8 * it) = o;
        }
    }
}
__device__ __forceinline__ void titem8_load(const TItem& I, f32x4 (&r)[8], int lane) {
    const float* p = I.W + (size_t)(I.k0 + 2 * (lane >> 3)) * I.N + I.n0 + 4 * (lane & 7);
#pragma unroll
    for (int i = 0; i < 4; ++i) { r[2 * i] = __builtin_nontemporal_load((const f32x4*)(p + (size_t)(16 * i) * I.N)); r[2 * i + 1] = __builtin_nontemporal_load((const f32x4*)(p + (size_t)(16 * i + 1) * I.N)); }
}
__device__ __forceinline__ float sc8(float v) { return __builtin_amdgcn_fmed3f(v * W8_SCALE, -448.f, 448.f); }
__device__ __forceinline__ unsigned char* titem8_outptr(const TItem& I, int lane) {
    const int g = lane >> 4, li = lane & 15, c = g & 1;
    const int nn = I.n0 + 16 * c + li, orow = I.rowoff + (I.gu ? ((nn >> 7) * 256 + (nn & 127)) : nn);
    return (unsigned char*)I.WT + (size_t)orow * I.K + I.k0 + (g >> 1) * 32;
}
__device__ __forceinline__ void titem8_store(unsigned char* op, const f32x4 (&r)[8], unsigned scr, int lane, bool doit = true) {
#pragma unroll
    for (int i = 0; i < 4; ++i) {
        const f32x4 ra = r[2 * i], rb = r[2 * i + 1];
        int w0 = __builtin_amdgcn_cvt_pk_fp8_f32(sc8(ra.x), sc8(rb.x), 0, false); w0 = __builtin_amdgcn_cvt_pk_fp8_f32(sc8(ra.y), sc8(rb.y), w0, true);
        int w1 = __builtin_amdgcn_cvt_pk_fp8_f32(sc8(ra.z), sc8(rb.z), 0, false); w1 = __builtin_amdgcn_cvt_pk_fp8_f32(sc8(ra.w), sc8(rb.w), w1, true);
        u32x2 w; w.x = (unsigned)w0; w.y = (unsigned)w1;
        asm volatile("ds_write_b64 %0, %1 offset:%c2" :: "v"(scr + lane * 8), "v"(w), "i"(i * 512) : "memory");
    }
    const int g = lane >> 4, li = lane & 15, c = g & 1;
    const unsigned ra_ = scr + ((li >> 2) * 64 + 32 * c + (li & 3) * 8) + (g >> 1) * 1024;
    wv4i16_t lo[2], hi[2];
    asm volatile("s_waitcnt lgkmcnt(0)" ::: "memory");
#pragma unroll
    for (int it = 0; it < 2; ++it)
        asm volatile("ds_read_b64_tr_b16 %0, %2 offset:%c3\n\tds_read_b64_tr_b16 %1, %2 offset:%c4" : "=&v"(lo[it]), "=&v"(hi[it]) : "v"(ra_), "i"(it * 512), "i"(it * 512 + 256) : "memory");
    asm volatile("s_waitcnt lgkmcnt(0)" ::: "memory"); __builtin_amdgcn_sched_barrier(0);
#pragma unroll
    for (int it = 0; it < 2; ++it) { const bf16x8 o = (bf16x8){lo[it][0], lo[it][1], lo[it][2], lo[it][3], hi[it][0], hi[it][1], hi[it][2], hi[it][3]}; if (doit) *(bf16x8*)(op + 16 * it) = o; }
}
constexpr int WI_IN = (DM / 64) * (DIN / 32), WI_OUT = (DM / 64) * (DM / 32), WI_G = (DM / 64) * (DE / 32), WI_D = (DE / 64) * (DM / 32);
constexpr int WI_DENSE = WI_IN + WI_OUT, WI_GU = NE * 2 * WI_G, WI_DN = NE * WI_D, WI_MOE = WI_GU + WI_DN;
#ifndef INPROJ_ITEMS_V
#define INPROJ_ITEMS_V 4096
#endif
constexpr int WI_SIDE = INPROJ_ITEMS_V;
constexpr int WI_MIX_END = WI_DENSE + WI_MOE - WI_SIDE;
__device__ __forceinline__ TItem wconv_item(const Args& a, int it) {
    bf16_t* WIN = (bf16_t*)(a.ws + WS_WIN); bf16_t* WOUT = (bf16_t*)(a.ws + WS_WOUT); bf16_t* W1 = (bf16_t*)(a.ws + WS_W1); bf16_t* W2 = (bf16_t*)(a.ws + WS_W2);
    TItem I; I.kscale = nullptr; I.cs_lo = 1.f; I.cs_n = 0; I.rowoff = 0; I.gu = 0;
    int r = it;
    if (r < WI_IN) { I.W = a.in[7]; I.K = DM; I.N = DIN; I.WT = WIN; I.cs_lo = QSCALE; I.cs_n = DNA; I.k0 = 64 * (r / (DIN / 32)); I.n0 = 32 * (r % (DIN / 32)); }
    else if ((r -= WI_IN) < WI_OUT) { I.W = a.in[14]; I.K = DM; I.N = DM; I.WT = WOUT; const int kb = r / (DM / 32); I.kscale = (kb * 64 < DNA) ? a.in[12] : (a.in[13] - DNA); I.k0 = 64 * kb; I.n0 = 32 * (r % (DM / 32)); }
    else { r -= WI_OUT;
        if (r < WI_GU) { const int e = r / (2 * WI_G); r -= e * (2 * WI_G); const int up = r / WI_G; r -= up * WI_G; I.W = (up ? a.in[18] : a.in[17]) + (size_t)e * DM * DE; I.K = DM; I.N = DE; I.WT = (bf16_t*)((unsigned char*)W1 + (size_t)e * 3072 * DM); I.gu = 1; I.rowoff = 128 * up; I.k0 = 64 * (r / (DE / 32)); I.n0 = 32 * (r % (DE / 32)); }
        else { r -= WI_GU; const int e = r / WI_D; r -= e * WI_D; I.W = a.in[19] + (size_t)e * DE * DM; I.K = DE; I.N = DM; I.WT = (bf16_t*)((unsigned char*)W2 + (size_t)e * DM * DE); I.k0 = 64 * (r / (DM / 32)); I.n0 = 32 * (r % (DM / 32)); } }
    return I;
}
__device__ __forceinline__ TItem wdown_item(const Args& a, int r) {
    TItem I; I.kscale = nullptr; I.cs_lo = 1.f; I.cs_n = 0; I.rowoff = 0; I.gu = 0;
    const int e = r / WI_D; r -= e * WI_D; I.W = a.in[19] + (size_t)e * DE * DM; I.K = DE; I.N = DM; I.WT = (bf16_t*)(a.ws + WS_W2 + (size_t)e * DM * DE); I.k0 = 64 * (r / (DM / 32)); I.n0 = 32 * (r % (DM / 32));
    return I;
}
template <bool KSC>
__device__ __forceinline__ void wconv_range(const Args& a, unsigned scr, int it, int last, int stride, int lane) {
    if (it >= last) return;
    f32x4 ra[8], rb[8];
    TItem Ia = wconv_item(a, it), Ib = Ia;
    if (KSC) titem_load(Ia, ra, lane); else titem8_load(Ia, ra, lane);
    for (; it < last; it += 2 * stride) {
        const bool hb = it + stride < last;
        if (hb) { Ib = wconv_item(a, it + stride); if (KSC) titem_load(Ib, rb, lane); else titem8_load(Ib, rb, lane); }
        if (KSC) titem_store<true>(Ia, ra, scr, lane); else titem8_store(titem8_outptr(Ia, lane), ra, scr, lane);
        if (!hb) break;
        const bool ha = it + 2 * stride < last;
        if (ha) { Ia = wconv_item(a, it + 2 * stride); if (KSC) titem_load(Ia, ra, lane); else titem8_load(Ia, ra, lane); }
        if (KSC) titem_store<true>(Ib, rb, scr, lane); else titem8_store(titem8_outptr(Ib, lane), rb, scr, lane);
        if (!ha) break;
    }
}
__device__ __forceinline__ void wconv_stream4(const Args& a, unsigned scr, int it, int last, int stride, int lane) {
    f32x4 r0[8], r1[8], r2[8], r3[8];
    if (it < last) titem8_load(wconv_item(a, it), r0, lane);
    if (it + stride < last) titem8_load(wconv_item(a, it + stride), r1, lane);
    if (it + 2 * stride < last) titem8_load(wconv_item(a, it + 2 * stride), r2, lane);
    if (it + 3 * stride < last) titem8_load(wconv_item(a, it + 3 * stride), r3, lane);
#define WCS_STEP(R, D) { const int i_ = it + (D) * stride; if (i_ >= last) break;                \
        { const TItem I = wconv_item(a, i_); titem8_store(titem8_outptr(I, lane), R, scr, lane); } \
        if (i_ + 4 * stride < last) titem8_load(wconv_item(a, i_ + 4 * stride), R, lane); }
    for (;; it += 4 * stride) { WCS_STEP(r0, 0) WCS_STEP(r1, 1) WCS_STEP(r2, 2) WCS_STEP(r3, 3) }
#undef WCS_STEP
}
__device__ __forceinline__ void phase_wconv(const Args& a, float* lds) {
    const int wave = __builtin_amdgcn_readfirstlane(threadIdx.x >> 6), lane = threadIdx.x & 63;
    wconv_range<true>(a, (unsigned)(size_t)(__attribute__((address_space(3))) unsigned char*)(lds) + 65536 + wave * 4096, blockIdx.x * 8 + wave, WI_DENSE, gridDim.x * 8, lane);
}

__device__ __forceinline__ const float* prenorm_row(const Args& a, int m) { return (m < NTOK) ? a.in[0] + (size_t)m * DM : a.in[2] + (size_t)(m - NTOK) * DM; }
__device__ __forceinline__ void prenorm_one(bf16_t* H, int m, const f32x4 (&v)[4], const f32x4 (&ga)[4], const f32x4 (&gb)[4], int lane) {
    float s = 0.f;
#pragma unroll
    for (int j = 0; j < 4; ++j) s += (v[j].x * v[j].x + v[j].y * v[j].y) + (v[j].z * v[j].z + v[j].w * v[j].w);
    const float rstd = rsqrtf(wave_sum(s) * (1.f / DM) + EPS);
    u32x2* o = (u32x2*)(H + (size_t)m * DM) + lane;
#pragma unroll
    for (int j = 0; j < 4; ++j) { const f32x4 y = (v[j] * rstd) * ga[j] + gb[j]; u32x2 w; w.x = cvtpk(y.x, y.y); w.y = cvtpk(y.z, y.w); o[64 * j] = w; }
}
__device__ __forceinline__ void phase_prenorm(const Args& a) {
    const int wave = threadIdx.x >> 6, lane = threadIdx.x & 63;
    const int gw = blockIdx.x * 8 + wave, NGW = gridDim.x * 8;
    const float* MOD = (const float*)(a.ws + WS_MOD); bf16_t* H = (bf16_t*)(a.ws + WS_H);
    const f32x4* n1 = (const f32x4*)a.in[6] + lane;
    const int NR = NTOK + NCTX, per = (NR + NGW - 1) / NGW, mbeg = gw * per, mend = (mbeg + per < NR) ? mbeg + per : NR;
    int mrcur = -1; f32x4 ga[4], gb[4];
    f32x4 v[3][4], vn[3][4];
#pragma unroll
    for (int r = 0; r < 3; ++r) if (mbeg + r < mend) { const f32x4* xr = (const f32x4*)prenorm_row(a, mbeg + r) + lane;
#pragma unroll
        for (int j = 0; j < 4; ++j) v[r][j] = __builtin_nontemporal_load(xr + 64 * j); }
    for (int m = mbeg; m < mend; m += 3) {
        const int nrow = (mend - m < 3) ? (mend - m) : 3;
#pragma unroll
        for (int r = 0; r < 3; ++r) if (m + 3 + r < mend) { const f32x4* xr = (const f32x4*)prenorm_row(a, m + 3 + r) + lane;
#pragma unroll
            for (int j = 0; j < 4; ++j) vn[r][j] = __builtin_nontemporal_load(xr + 64 * j); }
#pragma unroll
        for (int r = 0; r < 3; ++r) if (r < nrow) {
            const int mm = m + r, mr = (mm < NTOK) ? mm / SEQ : 8;
            if (mr != mrcur) {
                const f32x4* sh = (const f32x4*)(MOD + mr * NMOD) + lane; const f32x4* sc = (const f32x4*)(MOD + mr * NMOD + DM) + lane;
#pragma unroll
                for (int j = 0; j < 4; ++j) { ga[j] = n1[64 * j] * (sc[64 * j] + 1.f); gb[j] = sh[64 * j]; }
                mrcur = mr;
            }
            prenorm_one(H, mm, v[r], ga, gb, lane);
        }
#pragma unroll
        for (int r = 0; r < 3; ++r)
#pragma unroll
            for (int j = 0; j < 4; ++j) v[r][j] = vn[r][j];
    }
}

__device__ __forceinline__ void norm2_blocks(const Args& a, float* lds, int blk0, int blk1, int bstride) {
    const int tid = threadIdx.x, wave = tid >> 6, lane = tid & 63, e = lane & 15, kq = lane >> 4;
    const float* MOD = (const float*)(a.ws + WS_MOD); unsigned char* H8 = a.ws + WS_H2; float* AFF = (float*)(a.ws + WS_AFF);
    float* ybuf = lds;
    float* part = lds + 16 * 1028;
    constexpr int YP = 1028;
    float wreg[32];
    {   const float* wp = a.in[16] + (size_t)(128 * wave + 4 * kq) * NE + e;
#pragma unroll
        for (int j = 0; j < 8; ++j)
#pragma unroll
            for (int i = 0; i < 4; ++i) wreg[4 * j + i] = wp[(16 * j + i) * NE]; }
    const f32x4* n2 = (const f32x4*)a.in[15] + lane;
    const bf16_t* XNB = (const bf16_t*)(a.ws + WS_XNB);
    for (int blk = blk0; blk < blk1; blk += bstride) {
        const int row0 = blk * 64, b = row0 / SEQ;
        f32x4 ga[4], gb[4];
        {   const f32x4* sh = (const f32x4*)(MOD + b * NMOD + 3 * DM) + lane; const f32x4* sc = (const f32x4*)(MOD + b * NMOD + 4 * DM) + lane;
#pragma unroll
            for (int j = 0; j < 4; ++j) { ga[j] = n2[64 * j] * (sc[64 * j] + 1.f); gb[j] = sh[64 * j]; } }
        u32x2 vn[2][4];
#pragma unroll
        for (int r = 0; r < 2; ++r) { const u32x2* xr = (const u32x2*)(XNB + (size_t)(row0 + 8 * r + wave) * DM) + lane;
#pragma unroll
            for (int j = 0; j < 4; ++j) vn[r][j] = xr[64 * j]; }
        for (int t = 0; t < 4; ++t) {
            f32x4 v[2][4];
#pragma unroll
            for (int r = 0; r < 2; ++r)
#pragma unroll
                for (int j = 0; j < 4; ++j) v[r][j] = (f32x4){bflo(vn[r][j].x), bfhi(vn[r][j].x), bflo(vn[r][j].y), bfhi(vn[r][j].y)};
            if (t + 1 < 4) {
#pragma unroll
                for (int r = 0; r < 2; ++r) { const u32x2* xr = (const u32x2*)(XNB + (size_t)(row0 + 16 * (t + 1) + 8 * r + wave) * DM) + lane;
#pragma unroll
                    for (int j = 0; j < 4; ++j) vn[r][j] = xr[64 * j]; } }
#pragma unroll
            for (int r = 0; r < 2; ++r) {
                const int m = row0 + 16 * t + 8 * r + wave;
                float s = 0.f;
#pragma unroll
                for (int j = 0; j < 4; ++j) s += (v[r][j].x * v[r][j].x + v[r][j].y * v[r][j].y) + (v[r][j].z * v[r][j].z + v[r][j].w * v[r][j].w);
                const float rstd = rsqrtf(wave_sum(s) * (1.f / DM) + EPS);
                unsigned* o = (unsigned*)(H8 + (size_t)m * DM) + lane;
#pragma unroll
                for (int j = 0; j < 4; ++j) {
                    const f32x4 y = (v[r][j] * rstd) * ga[j] + gb[j];
                    o[64 * j] = cvt4_fp8(y.x * A8_SCALE, y.y * A8_SCALE, y.z * A8_SCALE, y.w * A8_SCALE);
                    *((f32x4*)(ybuf + (8 * r + wave) * YP) + 64 * j + lane) = y;
                }
            }
            LDS_BARRIER();
            {
                f32x4 D0 = (f32x4){0.f, 0.f, 0.f, 0.f}, D1 = D0;
                const float* yp = ybuf + e * YP + 128 * wave + 4 * kq;
#pragma unroll
                for (int j = 0; j < 8; ++j) { const f32x4 y4 = *(const f32x4*)(yp + 16 * j);
                    D0 = __builtin_amdgcn_mfma_f32_16x16x4f32(wreg[4 * j + 0], y4.x, D0, 0, 0, 0); D1 = __builtin_amdgcn_mfma_f32_16x16x4f32(wreg[4 * j + 1], y4.y, D1, 0, 0, 0);
                    D0 = __builtin_amdgcn_mfma_f32_16x16x4f32(wreg[4 * j + 2], y4.z, D0, 0, 0, 0); D1 = __builtin_amdgcn_mfma_f32_16x16x4f32(wreg[4 * j + 3], y4.w, D1, 0, 0, 0); }
                *(f32x4*)(part + ((lane & 15) * 8 + wave) * 16 + 4 * kq) = D0 + D1;
            }
            LDS_BARRIER();
            if (tid < 256) {
                const int rr = tid >> 4;
                float lg = 0.f;
#pragma unroll
                for (int w = 0; w < 8; ++w) lg += part[(rr * 8 + w) * 16 + e];
                float mx = lg;
                mx = row16_max(mx);
                const float ex = __expf(lg - mx); float den = ex;
                den = row16_sum(den);
                const int n = (row0 + 16 * t + rr) % SEQ;
                __hip_atomic_store((unsigned*)AFF + ((size_t)b * NE + e) * SEQ + n, __float_as_uint(ex / den), __ATOMIC_RELAXED, __HIP_MEMORY_SCOPE_AGENT);
            }
        }
        LDS_BARRIER();
    }
}

__device__ __forceinline__ void phase_norm2(const Args& a, float* lds) { norm2_blocks(a, lds, blockIdx.x, NTOK / 64, gridDim.x); }

__device__ __forceinline__ int wave_incl_scan(int v, int lane) {
    v += __builtin_amdgcn_update_dpp(0, v, 0x111, 0xF, 0xF, false); v += __builtin_amdgcn_update_dpp(0, v, 0x112, 0xF, 0xF, false);
    v += __builtin_amdgcn_update_dpp(0, v, 0x114, 0xF, 0xF, false); v += __builtin_amdgcn_update_dpp(0, v, 0x118, 0xF, 0xF, false);
    v += __builtin_amdgcn_update_dpp(0, v, 0x142, 0xA, 0xF, false); v += __builtin_amdgcn_update_dpp(0, v, 0x143, 0xC, 0xF, false);
    return v;
}
__device__ __forceinline__ void topk_items(const Args& a, float* lds, int item0, int item1, int istride) {
    const int t = threadIdx.x, wave = t >> 6, lane = t & 63;
    const float* AFF = (const float*)(a.ws + WS_AFF); float* GATE = (float*)(a.ws + WS_GATE); int* SEL = (int*)(a.ws + WS_SEL);
    int* IDX = (int*)(a.ws + WS_IDX);
    int* cntw = (int*)lds;
    int* wtot = (int*)(lds + 384);
    int* list = (int*)(lds + 320);
    int* cnt = (int*)(lds + 320 + 256);
    for (int item = item0; item < item1; item += istride) {
        const int half = item & 1, e = (item >> 1) & 15, b = item >> 5;
        const u32x4 k4 = ((const u32x4*)(AFF + ((size_t)b * NE + e) * SEQ))[t];
        unsigned prefix = 0u;
        for (int rnd = 0; rnd < 16; ++rnd) {
            const int lo = 29 - 2 * rnd;
            const unsigned b1 = (lo >= 0) ? (1u << lo) : 0u, b2 = (lo >= 0) ? (2u << lo) : 1u;
            const unsigned c1 = prefix | b1, c2 = prefix | b2, c3 = prefix | b1 | b2;
            int n1 = __builtin_popcountll(__ballot(k4.x >= c1)) + __builtin_popcountll(__ballot(k4.y >= c1)) + __builtin_popcountll(__ballot(k4.z >= c1)) + __builtin_popcountll(__ballot(k4.w >= c1));
            int n2 = __builtin_popcountll(__ballot(k4.x >= c2)) + __builtin_popcountll(__ballot(k4.y >= c2)) + __builtin_popcountll(__ballot(k4.z >= c2)) + __builtin_popcountll(__ballot(k4.w >= c2));
            int n3 = __builtin_popcountll(__ballot(k4.x >= c3)) + __builtin_popcountll(__ballot(k4.y >= c3)) + __builtin_popcountll(__ballot(k4.z >= c3)) + __builtin_popcountll(__ballot(k4.w >= c3));
            if (lane == 0) { cntw[(rnd * 3 + 0) * 8 + wave] = n1; cntw[(rnd * 3 + 1) * 8 + wave] = n2; cntw[(rnd * 3 + 2) * 8 + wave] = n3; }
            __syncthreads();
            int t1 = 0, t2 = 0, t3 = 0;
#pragma unroll
            for (int w = 0; w < 8; ++w) { t1 += cntw[(rnd * 3 + 0) * 8 + w]; t2 += cntw[(rnd * 3 + 1) * 8 + w]; t3 += cntw[(rnd * 3 + 2) * 8 + w]; }
            if (lo >= 0) prefix = (t3 >= CAP) ? c3 : ((t2 >= CAP) ? c2 : ((t1 >= CAP) ? c1 : prefix));
            else prefix = (t2 >= CAP) ? c2 : prefix;
        }
        const unsigned T = prefix;
        const int g0 = k4.x > T, g1 = k4.y > T, g2 = k4.z > T, g3 = k4.w > T;
        const int e0 = k4.x == T, e1 = k4.y == T, e2 = k4.z == T, e3 = k4.w == T;
        const int cg = g0 + g1 + g2 + g3, ce = e0 + e1 + e2 + e3;
        const int sg = wave_incl_scan(cg, lane), se = wave_incl_scan(ce, lane);
        if (lane == 63) { wtot[wave] = sg; wtot[8 + wave] = se; }
        __syncthreads();
        int gbase = 0, ebase = 0, ngt = 0;
#pragma unroll
        for (int w = 0; w < 8; ++w) { const int x = wtot[w], y = wtot[8 + w]; ngt += x; if (w < wave) { gbase += x; ebase += y; } }
        int gpos = gbase + sg - cg, epos = ebase + se - ce; const int need = CAP - ngt;
        int sl[4];
        sl[0] = g0 ? gpos : ((e0 && epos < need) ? ngt + epos : -1); gpos += g0; epos += e0;
        sl[1] = g1 ? gpos : ((e1 && epos < need) ? ngt + epos : -1); gpos += g1; epos += e1;
        sl[2] = g2 ? gpos : ((e2 && epos < need) ? ngt + epos : -1); gpos += g2; epos += e2;
        sl[3] = g3 ? gpos : ((e3 && epos < need) ? ngt + epos : -1);
        if ((t >> 8) == half) {
            const unsigned kk[4] = {k4.x, k4.y, k4.z, k4.w};
#pragma unroll
            for (int i = 0; i < 4; ++i) {
                const int n = 4 * t + i;
                SEL[((size_t)b * SEQ + n) * NE + e] = sl[i];
                if (sl[i] >= 0) { GATE[(b * NE + e) * CAP + sl[i]] = __uint_as_float(kk[i]); IDX[(e * NB + b) * CAP + sl[i]] = b * SEQ + n; }
            }
        }
        __syncthreads();
    }
}

__device__ __forceinline__ void phase_topk(const Args& a, float* lds) { topk_items(a, lds, blockIdx.x, NB * NE * 2, gridDim.x); }
__device__ __forceinline__ void phase_norm2_topk(const Args& a, float* lds) {
    const int blk = blockIdx.x, b = blk >> 5;
    norm2_blocks(a, lds, blk, blk + 1, 1);
    asm volatile("s_waitcnt vmcnt(0)" ::: "memory");
    LDS_BARRIER();
    if (threadIdx.x == 0) {
        unsigned* cnt = (unsigned*)(a.ws + WS_PCNT) + 64 * b;
        __hip_atomic_fetch_add(cnt, 1u, __ATOMIC_RELAXED, __HIP_MEMORY_SCOPE_AGENT);
        unsigned sp = 0;
        while (__hip_atomic_load(cnt, __ATOMIC_RELAXED, __HIP_MEMORY_SCOPE_AGENT) < 32u) { __builtin_amdgcn_s_sleep(1); if (++sp > (1u << 22)) break; }
        __builtin_amdgcn_fence(__ATOMIC_ACQUIRE, "agent");
        asm volatile("s_waitcnt vmcnt(0)" ::: "memory");
    }
    LDS_BARRIER();
    const int item = b * 32 + (blk & 31);
    topk_items(a, lds, item, item + 1, 1);
}

__device__ __forceinline__ void final_gather(const Args& a, int m, int mysel, f32x4 (&acc)[4], int lane) {
    const unsigned char* Y = a.ws + WS_Y; const int b = m / SEQ;
#pragma unroll
    for (int j = 0; j < 4; ++j) acc[j] = (f32x4){0.f, 0.f, 0.f, 0.f};
    unsigned long long msk = __ballot(mysel >= 0);
    while (msk) {
        const int e = __builtin_ctzll(msk); msk &= msk - 1;
        const int sl = __builtin_amdgcn_readlane(mysel, e);
        const unsigned* yr = (const unsigned*)(Y + (size_t)((e * NB + b) * CAP + sl) * DM) + lane;
#pragma unroll
        for (int j = 0; j < 4; ++j) { const unsigned w = yr[64 * j]; const f32x2 lo = __builtin_amdgcn_cvt_pk_f32_fp8((int)w, false), hi = __builtin_amdgcn_cvt_pk_f32_fp8((int)w, true);
            acc[j].x += lo.x; acc[j].y += lo.y; acc[j].z += hi.x; acc[j].w += hi.y; }
    }
#pragma unroll
    for (int j = 0; j < 4; ++j) acc[j] = acc[j] * (1.f / Y8_SCALE);
}
__device__ __forceinline__ void final_gather3(const Args& a, int m, int nrow, const int (&sel)[3], f32x4 (&acc)[3][4], int lane) {
    const unsigned char* Y = a.ws + WS_Y;
    unsigned long long msk[3];
#pragma unroll
    for (int r = 0; r < 3; ++r) { msk[r] = (r < nrow) ? __ballot(sel[r] >= 0) : 0ull;
#pragma unroll
        for (int j = 0; j < 4; ++j) acc[r][j] = (f32x4){0.f, 0.f, 0.f, 0.f}; }
    while (msk[0] | msk[1] | msk[2]) {
        unsigned w[3][4];
#pragma unroll
        for (int r = 0; r < 3; ++r) {
            if (msk[r]) { const int e = __builtin_ctzll(msk[r]); const int sl = __builtin_amdgcn_readlane(sel[r], e); const int b = (m + r) / SEQ;
                const unsigned* yr = (const unsigned*)(Y + (size_t)((e * NB + b) * CAP + sl) * DM) + lane;
#pragma unroll
                for (int j = 0; j < 4; ++j) w[r][j] = yr[64 * j]; }
            else {
#pragma unroll
                for (int j = 0; j < 4; ++j) w[r][j] = 0u; }
        }
#pragma unroll
        for (int r = 0; r < 3; ++r) { msk[r] &= msk[r] - 1ull;
#pragma unroll
            for (int j = 0; j < 4; ++j) { const f32x2 lo = __builtin_amdgcn_cvt_pk_f32_fp8((int)w[r][j], false), hi = __builtin_amdgcn_cvt_pk_f32_fp8((int)w[r][j], true);
                acc[r][j].x += lo.x; acc[r][j].y += lo.y; acc[r][j].z += hi.x; acc[r][j].w += hi.y; } }
    }
#pragma unroll
    for (int r = 0; r < 3; ++r)
#pragma unroll
        for (int j = 0; j < 4; ++j) acc[r][j] = acc[r][j] * (1.f / Y8_SCALE);
}
__device__ __forceinline__ void final_finish(float* dst, int m, const f32x4 (&xv)[4], const f32x4 (&acc)[4], const f32x4 (&g2)[4], const f32x4 (&nf)[4], int lane) {
    f32x4* xr = (f32x4*)(dst + (size_t)m * DM) + lane;
    f32x4 v[4]; float s = 0.f;
#pragma unroll
    for (int j = 0; j < 4; ++j) { v[j] = xv[j] + g2[j] * acc[j]; s += (v[j].x * v[j].x + v[j].y * v[j].y) + (v[j].z * v[j].z + v[j].w * v[j].w); }
    const float rstd = rsqrtf(wave_sum(s) * (1.f / DM) + EPS);
#pragma unroll
    for (int j = 0; j < 4; ++j) __builtin_nontemporal_store((v[j] * rstd) * nf[j], xr + 64 * j);
}
__device__ __forceinline__ void phase_final(const Args& a, float* dst) {
    const int wave = threadIdx.x >> 6, lane = threadIdx.x & 63;
    const int gw = blockIdx.x * 8 + wave, NGW = gridDim.x * 8;
    const int* SEL = (const int*)(a.ws + WS_SEL);
    const bf16_t* XNB = (const bf16_t*)(a.ws + WS_XNB);
    const int per = (NTOK + NGW - 1) / NGW, mbeg = gw * per, mend = (mbeg + per < NTOK) ? mbeg + per : NTOK;
    u32x2 xw[3][4], xn[3][4]; int sw[3], sn[3];
    f32x4 g2r[4], nfr[4]; int bcur = -1;
#pragma unroll
    for (int j = 0; j < 4; ++j) nfr[j] = ((const f32x4*)a.in[20] + lane)[64 * j];
#pragma unroll
    for (int r = 0; r < 3; ++r) { const int mm = mbeg + r; sw[r] = -1;
        if (mm < mend) { sw[r] = (lane < NE) ? SEL[(size_t)mm * NE + lane] : -1; const u32x2* xr = (const u32x2*)(XNB + (size_t)mm * DM) + lane;
#pragma unroll
            for (int j = 0; j < 4; ++j) xw[r][j] = xr[64 * j]; } }
    for (int m = mbeg; m < mend; m += 3) {
#pragma unroll
        for (int r = 0; r < 3; ++r) { const int mm = m + 3 + r; sn[r] = -1;
            if (mm < mend) { sn[r] = (lane < NE) ? SEL[(size_t)mm * NE + lane] : -1; const u32x2* xr = (const u32x2*)(XNB + (size_t)mm * DM) + lane;
#pragma unroll
                for (int j = 0; j < 4; ++j) xn[r][j] = xr[64 * j]; } }
        f32x4 acc[3][4];
        final_gather3(a, m, (mend - m < 3) ? (mend - m) : 3, sw, acc, lane);
#pragma unroll
        for (int r = 0; r < 3; ++r) if (m + r < mend) {
            f32x4 xv[4];
#pragma unroll
            for (int j = 0; j < 4; ++j) xv[j] = (f32x4){bflo(xw[r][j].x), bfhi(xw[r][j].x), bflo(xw[r][j].y), bfhi(xw[r][j].y)};
            const int bb = (m + r) / SEQ;
            if (bb != bcur) { const f32x4* gp = (const f32x4*)((const float*)(a.ws + WS_MOD) + bb * NMOD + 5 * DM) + lane;
#pragma unroll
                for (int j = 0; j < 4; ++j) g2r[j] = gp[64 * j];
                bcur = bb; }
            final_finish(dst, m + r, xv, acc[r], g2r, nfr, lane);
        }
#pragma unroll
        for (int r = 0; r < 3; ++r) { sw[r] = sn[r];
#pragma unroll
            for (int j = 0; j < 4; ++j) xw[r][j] = xn[r][j]; }
    }
}

namespace pg8 {
#define PG8_LAS __attribute__((address_space(3)))
typedef unsigned short bf16_t;
typedef short bf16x8 __attribute__((ext_vector_type(8)));
typedef float f32x4 __attribute__((ext_vector_type(4)));
typedef unsigned u32x4 __attribute__((ext_vector_type(4)));
typedef int v4i_t __attribute__((ext_vector_type(4)));
typedef int v8i_t __attribute__((ext_vector_type(8)));
constexpr int BM = 256, BK = 64, HALF = 128, HTB = HALF * BK * 2  , STAGE_BYTES = 8 * HTB, NXCD = 8, WGM = 8;

__host__ __device__ __forceinline__ int lds_byte(int r, int c) { const int st = (r >> 4) * 2 + (c >> 5), rr = r & 15, cc = c & 31, ob = rr * 64 + cc * 2; return st * 1024 + (ob ^ (((ob >> 9) & 1) << 5)); }
__host__ __device__ __forceinline__ void stage_rc(int b, int& R, int& C) { const int st = b / 1024, sb = b % 1024, swz = sb ^ (((sb >> 9) & 1) << 5); R = (st >> 1) * 16 + swz / 64; C = (st & 1) * 32 + (swz % 64) / 2; }
__host__ __device__ __forceinline__ int perm32(int rho) { const int n = rho >> 4, i = rho & 15; return 8 * (i >> 2) + 4 * n + (i & 3); }

struct Unit { int pm, pn; };
struct Gemm { const bf16_t* A; const bf16_t* Bt; int M, N, K; const int* gidx; };
struct HostW { const Args* a; int first, stride, last; unsigned scr; };
template <class Epi, class Sched, bool ALIGN_EPI = false, bool SP2 = false, bool GATHER = false, bool F8 = false, bool HOST = false>
__device__ __forceinline__ void gemm_phase(PG8_LAS unsigned char* lds, const Gemm g, const Sched& S, const Epi& E, const HostW hw = HostW{nullptr, 0, 0, 0, 0u}) {
    const int tid = threadIdx.x, wid = __builtin_amdgcn_readfirstlane(tid >> 6), lane = tid & 63, wr = wid >> 2, wc = wid & 3, fr = lane & 15, fq = lane >> 4;
    const int K = g.K, nt = K / BK;
    unsigned voffA[2], voffB[2];
#pragma unroll
    for (int i = 0; i < 2; ++i) { int R, C; stage_rc(tid * 16 + i * 8192, R, C); const int Rb = Epi::PERM ? ((R & ~31) + perm32(R & 31)) : R;
        voffA[i] = (unsigned)(R * K + C) * 2u; voffB[i] = (unsigned)(Rb * K + C) * 2u; }
    const size_t kstep = (size_t)(BK * 2);
    const size_t hstep = (size_t)HALF * K * 2;
    const size_t tstep = 2 * hstep;
    const unsigned ldsw = (unsigned)wid * 1024u;
    const int aoff = lds_byte(wr * 64 + fr, fq * 8), boff = lds_byte(wc * 32 + fr, fq * 8);
    const int sc8 = 0x7F7F7F7F;
    constexpr int KSTEP_B = 1024;
#define PG8_SA(b, h) (((b) * 2 + (h)) * HTB)
#define PG8_SB(b, h) ((4 + (b) * 2 + (h)) * HTB)
#define PG8_STAGE(bufoff, gbase, voff) do { _Pragma("unroll") for (int _i = 0; _i < 2; ++_i) \
        __builtin_amdgcn_global_load_lds((const unsigned*)((const char*)(gbase) + (voff)[_i]), (PG8_LAS unsigned*)(lds + (bufoff) + ldsw + _i * 8192), 16, 0, 0); } while (0)
    unsigned vAc[2][2], vAn[2][2], vA2[2][2];
#define PG8_GIDX(dst, pm_) do { _Pragma("unroll") for (int _h = 0; _h < 2; ++_h) _Pragma("unroll") for (int _i = 0; _i < 2; ++_i) { int R_, C_; stage_rc(tid * 16 + _i * 8192, R_, C_); \
        dst[_h][_i] = (unsigned)(g.gidx[(pm_) * BM + _h * HALF + R_] * K + C_) * 2u; } } while (0)
#define PG8_STAGEA(bufoff, base, h, vsel) do { if constexpr (GATHER) { PG8_STAGE(bufoff, base, vsel[h]); } else { PG8_STAGE(bufoff, (base) + (h) * hstep, voffA); } } while (0)
#define PG8_LDA(dst, b, h) do { _Pragma("unroll") for (int m = 0; m < 4; ++m) _Pragma("unroll") for (int k = 0; k < 2; ++k) dst[m][k] = *(const PG8_LAS bf16x8*)(lds + PG8_SA(b, h) + aoff + m * 2048 + k * KSTEP_B); } while (0)
#define PG8_LDB(dst, b, h) do { _Pragma("unroll") for (int n = 0; n < 2; ++n) _Pragma("unroll") for (int k = 0; k < 2; ++k) dst[n][k] = *(const PG8_LAS bf16x8*)(lds + PG8_SB(b, h) + boff + n * 2048 + k * KSTEP_B); } while (0)
#define PG8_CAT8(x, y) __builtin_shufflevector(__builtin_bit_cast(v4i_t, x), __builtin_bit_cast(v4i_t, y), 0, 1, 2, 3, 4, 5, 6, 7)
#define PG8_MMA(ai, bj, At, Bt) do { __builtin_amdgcn_s_setprio(1); _Pragma("unroll") for (int m = 0; m < 4; ++m) _Pragma("unroll") for (int n = 0; n < 2; ++n) { \
        if constexpr (F8) { const v8i_t b8_ = PG8_CAT8(Bt[n][0], Bt[n][1]), a8_ = PG8_CAT8(At[m][0], At[m][1]); \
            asm volatile("s_nop 1\n\tv_mfma_scale_f32_16x16x128_f8f6f4 %0, %1, %2, %0, %3, %3 op_sel_hi:[0,0,0]" : "+v"(acc[ai][bj][m][n]) : "v"(b8_), "v"(a8_), "v"(sc8)); } \
        else { _Pragma("unroll") for (int k = 0; k < 2; ++k) acc[ai][bj][m][n] = __builtin_amdgcn_mfma_f32_16x16x32_bf16(Bt[n][k], At[m][k], acc[ai][bj][m][n], 0, 0, 0); } } __builtin_amdgcn_s_setprio(0); } while (0)
#define PG8_WAIT_V(n) asm volatile("s_waitcnt vmcnt(" #n ")" ::: "memory")
#define PG8_WAIT_L(n) asm volatile("s_waitcnt lgkmcnt(" #n ")" ::: "memory")
#define PG8_BAR __builtin_amdgcn_s_barrier()
#define PG8_SCHED __builtin_amdgcn_sched_barrier(0)
    Unit cur, nxt; int ui = 0;
    if (!S.next(0, cur)) return;
    f32x4 acc[2][2][4][2];
#pragma unroll
    for (int a = 0; a < 2; ++a)
#pragma unroll
        for (int b = 0; b < 2; ++b)
#pragma unroll
            for (int m = 0; m < 4; ++m)
#pragma unroll
                for (int n = 0; n < 2; ++n) acc[a][b][m][n] = (f32x4){0.f, 0.f, 0.f, 0.f};
    bf16x8 At[4][2], B0[2][2], B1[2][2];
    const char* cA = (const char*)g.A + (GATHER ? (size_t)0 : (size_t)cur.pm * tstep); const char* cB = (const char*)g.Bt + (size_t)cur.pn * tstep;
    if constexpr (GATHER) { PG8_GIDX(vAc, cur.pm); }
    S.a_ready(cur);
    if constexpr (Epi::MIDSCALE) E.unit_begin(cur, ui, tid);
    if constexpr (SP2) {
        PG8_STAGE(PG8_SB(0, 0), cB, voffB); PG8_STAGE(PG8_SB(0, 1), cB + hstep, voffB); PG8_STAGEA(PG8_SA(0, 0), cA, 0, vAc); PG8_STAGEA(PG8_SA(0, 1), cA, 1, vAc);
        if (wr == 1) PG8_BAR;
        PG8_WAIT_V(2); PG8_BAR;
        PG8_STAGE(PG8_SB(1, 0), cB + kstep, voffB); PG8_STAGEA(PG8_SA(1, 0), cA + kstep, 0, vAc); PG8_STAGE(PG8_SB(1, 1), cB + hstep + kstep, voffB);
        PG8_WAIT_V(6); PG8_BAR;
    } else {
        PG8_STAGE(PG8_SB(0, 0), cB, voffB); PG8_STAGE(PG8_SA(0, 0), cA, voffA); PG8_STAGE(PG8_SB(0, 1), cB + hstep, voffB); PG8_STAGE(PG8_SA(0, 1), cA + hstep, voffA);
        if (wr == 1) PG8_BAR;
        PG8_WAIT_V(4); PG8_BAR;
        PG8_STAGE(PG8_SB(1, 0), cB + kstep, voffB); PG8_STAGE(PG8_SA(1, 0), cA + kstep, voffA); PG8_STAGE(PG8_SB(1, 1), cB + hstep + kstep, voffB);
        PG8_WAIT_V(6); PG8_BAR;
    }
    for (;;) {
        const bool has_next = S.next(ui + 1, nxt);
        const char* nA = (has_next && !GATHER) ? (const char*)g.A + (size_t)nxt.pm * tstep : cA; const char* nB = has_next ? (const char*)g.Bt + (size_t)nxt.pn * tstep : cB;
        if constexpr (GATHER) { if (has_next) { PG8_GIDX(vAn, nxt.pm); } else {
#pragma unroll
            for (int _h = 0; _h < 2; ++_h) { vAn[_h][0] = vAc[_h][0]; vAn[_h][1] = vAc[_h][1]; } } }
        for (int t = 0; t < nt; t += 2) {
            const bool last = (t == nt - 2);
            const char* a1 = cA + (size_t)(t + 1) * kstep;
            const char* a2 = last ? nA : cA + (size_t)(t + 2) * kstep; const char* b2 = last ? nB : cB + (size_t)(t + 2) * kstep;
            const char* a3 = a2 + kstep; const char* b3 = b2 + kstep;
            if (last && has_next) S.a_ready(nxt);
            if constexpr (GATHER) {
#pragma unroll
                for (int _h = 0; _h < 2; ++_h) { vA2[_h][0] = last ? vAn[_h][0] : vAc[_h][0]; vA2[_h][1] = last ? vAn[_h][1] : vAc[_h][1]; } }
            if constexpr (Epi::MIDSCALE) { if (t == nt / 2) E.midscale(acc, cur, ui, wr, fr); }
            if constexpr (SP2) {
            PG8_LDB(B0, 0, 0); PG8_LDB(B1, 0, 1); PG8_SCHED; PG8_LDA(At, 0, 0); PG8_STAGEA(PG8_SA(1, 1), a1, 1, vAc);
            PG8_WAIT_V(8); PG8_WAIT_L(0); PG8_BAR; PG8_MMA(0, 0, At, B0); PG8_MMA(0, 1, At, B1); PG8_BAR; PG8_SCHED;
            PG8_LDA(At, 0, 1); PG8_STAGE(PG8_SB(0, 0), b2, voffB); PG8_STAGE(PG8_SB(0, 1), b2 + hstep, voffB); PG8_STAGEA(PG8_SA(0, 0), a2, 0, vA2);
            PG8_WAIT_V(8); PG8_WAIT_L(0); PG8_BAR; PG8_MMA(1, 0, At, B0); PG8_MMA(1, 1, At, B1); PG8_BAR; PG8_SCHED;
            PG8_LDB(B0, 1, 0); PG8_LDB(B1, 1, 1); PG8_SCHED; PG8_LDA(At, 1, 0); PG8_STAGEA(PG8_SA(0, 1), a2, 1, vA2);
            PG8_WAIT_V(8); PG8_WAIT_L(0); PG8_BAR; PG8_MMA(0, 0, At, B0); PG8_MMA(0, 1, At, B1); PG8_BAR; PG8_SCHED;
            PG8_LDA(At, 1, 1); PG8_STAGE(PG8_SB(1, 0), b3, voffB); PG8_STAGE(PG8_SB(1, 1), b3 + hstep, voffB); PG8_STAGEA(PG8_SA(1, 0), a3, 0, vA2);
            PG8_WAIT_V(8); PG8_WAIT_L(0); PG8_BAR; PG8_MMA(1, 0, At, B0); PG8_MMA(1, 1, At, B1); PG8_BAR; PG8_SCHED;
            } else {
            PG8_LDB(B0, 0, 0); PG8_SCHED; PG8_LDA(At, 0, 0); PG8_STAGE(PG8_SA(1, 1), a1 + hstep, voffA);
            PG8_WAIT_L(8); PG8_BAR; PG8_WAIT_L(0); PG8_MMA(0, 0, At, B0); PG8_BAR; PG8_SCHED;
            PG8_LDB(B1, 0, 1); PG8_STAGE(PG8_SB(0, 0), b2, voffB);
            PG8_BAR; PG8_WAIT_L(0); PG8_MMA(0, 1, At, B1); PG8_BAR;
            PG8_LDA(At, 0, 1); PG8_STAGE(PG8_SA(0, 0), a2, voffA);
            PG8_BAR; PG8_WAIT_L(0); PG8_MMA(1, 0, At, B0); PG8_BAR; PG8_SCHED;
            PG8_STAGE(PG8_SB(0, 1), b2 + hstep, voffB);
            PG8_WAIT_V(6); PG8_BAR; PG8_MMA(1, 1, At, B1); PG8_BAR;
            PG8_LDB(B0, 1, 0); PG8_SCHED; PG8_LDA(At, 1, 0); PG8_STAGE(PG8_SA(0, 1), a2 + hstep, voffA);
            PG8_WAIT_L(8); PG8_BAR; PG8_WAIT_L(0); PG8_MMA(0, 0, At, B0); PG8_BAR; PG8_SCHED;
            PG8_LDB(B1, 1, 1); PG8_STAGE(PG8_SB(1, 0), b3, voffB);
            PG8_BAR; PG8_WAIT_L(0); PG8_MMA(0, 1, At, B1); PG8_BAR;
            PG8_LDA(At, 1, 1); PG8_STAGE(PG8_SA(1, 0), a3, voffA);
            PG8_BAR; PG8_WAIT_L(0); PG8_MMA(1, 0, At, B0); PG8_BAR; PG8_SCHED;
            PG8_STAGE(PG8_SB(1, 1), b3 + hstep, voffB);
            PG8_WAIT_V(6); PG8_BAR; PG8_MMA(1, 1, At, B1); PG8_BAR;
            }
        }
        if constexpr (ALIGN_EPI) { if (wr == 0) PG8_BAR; }
        if constexpr (F8) asm volatile("s_nop 15\n\ts_nop 7" ::: "memory");
        if constexpr (HOST) {
            E.part(acc, cur, wr, wc, fr, fq, 0);
            PG8_SCHED;
            ::f32x4 hr[8]; const int hit0 = hw.first + ui * hw.stride; const bool hhave = hit0 < hw.last; const int hit = hhave ? hit0 : hw.first;
            const TItem HI = wdown_item(*hw.a, hit); titem8_load(HI, hr, lane);
            PG8_SCHED;
            E.part(acc, cur, wr, wc, fr, fq, 1); S.done(cur);
            PG8_SCHED;
            titem8_store(titem8_outptr(HI, lane), hr, hw.scr, lane, hhave);
        } else
        if constexpr (!Epi::AFTER_DRAIN) { if constexpr (Epi::MIDSCALE) E.finish(acc, cur, ui, wr, wc, fr, fq); else E(acc, cur, wr, wc, fr, fq); S.done(cur); }
        if (!has_next) break;
#pragma unroll
        for (int a = 0; a < 2; ++a)
#pragma unroll
            for (int b = 0; b < 2; ++b)
#pragma unroll
                for (int m = 0; m < 4; ++m)
#pragma unroll
                    for (int n = 0; n < 2; ++n) acc[a][b][m][n] = (f32x4){0.f, 0.f, 0.f, 0.f};
        cur = nxt; cA = nA; cB = nB; ++ui;
        if constexpr (GATHER) {
#pragma unroll
            for (int _h = 0; _h < 2; ++_h) { vAc[_h][0] = vAn[_h][0]; vAc[_h][1] = vAn[_h][1]; } }
        if constexpr (Epi::MIDSCALE) E.unit_begin(cur, ui, tid);
        if constexpr (ALIGN_EPI) { if (wr == 1) PG8_BAR; }
    }
    PG8_WAIT_V(0);
    if constexpr (!ALIGN_EPI) { if (wr == 0) PG8_BAR; }
    PG8_BAR;
    if constexpr (Epi::AFTER_DRAIN) { E.fused(acc, cur, wr, wc, fr, fq, lds, wid, lane); S.done(cur); }
#undef PG8_SA
#undef PG8_SB
#undef PG8_STAGE
#undef PG8_STAGEA
#undef PG8_GIDX
#undef PG8_LDA
#undef PG8_LDB
#undef PG8_MMA
#undef PG8_CAT8
#undef PG8_WAIT_V
#undef PG8_WAIT_L
#undef PG8_BAR
#undef PG8_SCHED
}
}
namespace pg8 {
struct GroupedOrder {
    int nwg, npn, pn_grouped, G, c, nextra;
    __device__ __forceinline__ void init(int nwg_, int npn_, int pn_grouped_, int G_, int c_, int nextra_) { nwg = nwg_; npn = npn_; pn_grouped = pn_grouped_; G = G_; c = c_; nextra = nextra_; }
    __device__ __forceinline__ bool next(int i, Unit& u) const {
        const int L = i * G + c; if (L >= nwg + nextra) return false;
        if (L >= nwg) { const int x = L - nwg; u.pm = 64 + (x >> 2); u.pn = 2 + (x & 3); return true; }
        int wgid = L; { const int q = nwg / NXCD, r = nwg % NXCD, xcd = wgid % NXCD, off = wgid / NXCD; wgid = (xcd < r ? xcd * (q + 1) : r * (q + 1) + (xcd - r) * q) + off; }
        const int upg = 8 * npn, grp = wgid / upg, loc = wgid % upg;
        u.pm = grp * 8 + (loc & 7); u.pn = (pn_grouped ? grp * npn : 0) + (loc >> 3); return true;
    }
    __device__ __forceinline__ void a_ready(const Unit&) const {}
    __device__ __forceinline__ void done(const Unit&) const {}
};
__device__ __forceinline__ unsigned cvt_pk_bf16(float lo, float hi) { return ::cvtpk(lo, hi); }
__device__ __forceinline__ float gelu_fast(float x) { constexpr float C = -1.5957691216057308f * LOG2E; const float u = x * __builtin_fmaf(x * x, 0.044715f * C, C); return x * __builtin_amdgcn_rcpf(1.f + __builtin_amdgcn_exp2f(u)); }
__device__ __forceinline__ float silu_fast(float x) { return x * __builtin_amdgcn_rcpf(1.f + __builtin_amdgcn_exp2f(-LOG2E * x)); }

struct EpiInproj {
    static constexpr bool PERM = true, AFTER_DRAIN = false, MIDSCALE = false;
    bf16_t* Z; bf16_t* KVC;
    __device__ __forceinline__ void operator()(const f32x4 (&acc)[2][2][4][2], const Unit& u, int wr, int wc, int fr, int fq) const {
        const bool isctx = u.pm >= 64, act = (!isctx) && u.pn >= 6;
        bf16_t* base = isctx ? KVC : Z; const int ldc = isctx ? DM : DIN;
        const int row0 = (isctx ? (u.pm - 64) : u.pm) * BM + wr * 64 + fr, col0 = (isctx ? (u.pn - 2) : u.pn) * BM + wc * 32 + 8 * fq;
#pragma unroll
        for (int ai = 0; ai < 2; ++ai)
#pragma unroll
            for (int m = 0; m < 4; ++m) { bf16_t* rowp = base + (size_t)(row0 + ai * HALF + m * 16) * ldc + col0;
#pragma unroll
                for (int bj = 0; bj < 2; ++bj) { f32x4 v0 = acc[ai][bj][m][0], v1 = acc[ai][bj][m][1];
                    if (act) { v0 = (f32x4){gelu_fast(v0[0]), gelu_fast(v0[1]), gelu_fast(v0[2]), gelu_fast(v0[3])}; v1 = (f32x4){gelu_fast(v1[0]), gelu_fast(v1[1]), gelu_fast(v1[2]), gelu_fast(v1[3])}; }
                    u32x4 w; w.x = cvt_pk_bf16(v0[0], v0[1]); w.y = cvt_pk_bf16(v0[2], v0[3]); w.z = cvt_pk_bf16(v1[0], v1[1]); w.w = cvt_pk_bf16(v1[2], v1[3]);
                    *(u32x4*)(rowp + bj * HALF) = w; } }
    }
};
struct EpiOutproj {
    static constexpr bool PERM = false, AFTER_DRAIN = false, MIDSCALE = true;
    const float* x; bf16_t* out; const float* MOD; const float* SS; PG8_LAS float* tab;
    __device__ __forceinline__ void unit_begin(const Unit& u, int ui, int tid) const {
        if (tid < BM) { const f32x2 ss = *(const f32x2*)(SS + (size_t)(u.pm * BM + tid) * 2);
            const float ra = rsqrtf(ss.x * (1.f / 512.f) + EPS), rb = rsqrtf(ss.y * (1.f / 512.f) + EPS);
            PG8_LAS float* t = tab + ((ui & 1) * BM + tid) * 2; t[0] = ra / rb; t[1] = rb; }
    }
    __device__ __forceinline__ void midscale(f32x4 (&acc)[2][2][4][2], const Unit& u, int ui, int wr, int fr) const {
#pragma unroll
        for (int ai = 0; ai < 2; ++ai)
#pragma unroll
            for (int m = 0; m < 4; ++m) { const float r = tab[((ui & 1) * BM + ai * HALF + wr * 64 + m * 16 + fr) * 2];
#pragma unroll
                for (int bj = 0; bj < 2; ++bj)
#pragma unroll
                    for (int n = 0; n < 2; ++n) acc[ai][bj][m][n] = acc[ai][bj][m][n] * r; }
    }
    __device__ __forceinline__ void finish(const f32x4 (&acc)[2][2][4][2], const Unit& u, int ui, int wr, int wc, int fr, int fq) const {
        const int b = u.pm >> 3, col0 = u.pn * BM + wc * 32 + 4 * fq;
        f32x4 g1[2][2];
#pragma unroll
        for (int bj = 0; bj < 2; ++bj)
#pragma unroll
            for (int n = 0; n < 2; ++n) g1[bj][n] = *(const f32x4*)(MOD + b * NMOD + 2 * DM + col0 + bj * HALF + n * 16);
#pragma unroll
        for (int ai = 0; ai < 2; ++ai)
#pragma unroll
            for (int m = 0; m < 4; ++m) { const int r = ai * HALF + wr * 64 + m * 16 + fr; const float rb = tab[((ui & 1) * BM + r) * 2 + 1];
                const size_t off = (size_t)(u.pm * BM + r) * DM + col0;
#pragma unroll
                for (int bj = 0; bj < 2; ++bj)
#pragma unroll
                    for (int n = 0; n < 2; ++n) { const f32x4 xv = *(const f32x4*)(x + off + bj * HALF + n * 16); const f32x4 r = xv + g1[bj][n] * (acc[ai][bj][m][n] * rb); u32x2 w; w.x = cvt_pk_bf16(r[0], r[1]); w.y = cvt_pk_bf16(r[2], r[3]); *(u32x2*)(out + off + bj * HALF + n * 16) = w; } }
    }
};
struct EpiMoe1 {
    static constexpr bool PERM = true, AFTER_DRAIN = false, MIDSCALE = false;
    unsigned char* ACT;
    static __device__ __forceinline__ float su8(float ag, float au) {
        constexpr float SI_ = 1.f / (A8_SCALE * W8_SCALE), K8 = 1.f / (A8_SCALE * SI_ * SI_), C8 = -LOG2E * SI_;
        const float e = __builtin_amdgcn_exp2f(ag * C8);
        return (ag * au) * __builtin_amdgcn_rcpf(__builtin_fmaf(e, K8, K8));
    }
    __device__ __forceinline__ void operator()(const f32x4 (&acc)[2][2][4][2], const Unit& u, int wr, int wc, int fr, int fq) const { part(acc, u, wr, wc, fr, fq, 0); part(acc, u, wr, wc, fr, fq, 1); }
    __device__ __forceinline__ void part(const f32x4 (&acc)[2][2][4][2], const Unit& u, int wr, int wc, int fr, int fq, const int ai) const {
        const int f0 = (u.pn % 12) * HALF + wc * 32 + 8 * fq;
        constexpr float SI = 1.f / (A8_SCALE * W8_SCALE);
        {
#pragma unroll
            for (int m = 0; m < 4; ++m) { unsigned char* rowp = ACT + (size_t)(u.pm * BM + ai * HALF + wr * 64 + m * 16 + fr) * DE + f0;
                const f32x4 ag0 = acc[ai][0][m][0], ag1 = acc[ai][0][m][1], au0 = acc[ai][1][m][0], au1 = acc[ai][1][m][1];
                u32x2 w; w.x = cvt4_fp8(su8(ag0[0], au0[0]), su8(ag0[1], au0[1]), su8(ag0[2], au0[2]), su8(ag0[3], au0[3]));
                w.y = cvt4_fp8(su8(ag1[0], au1[0]), su8(ag1[1], au1[1]), su8(ag1[2], au1[2]), su8(ag1[3], au1[3]));
                *(u32x2*)rowp = w; }
        }
    }
};
struct EpiMoe2 {
    static constexpr bool PERM = true, AFTER_DRAIN = false, MIDSCALE = false;
    unsigned char* Y; const float* GATE;
    __device__ __forceinline__ void operator()(const f32x4 (&acc)[2][2][4][2], const Unit& u, int wr, int wc, int fr, int fq) const {
        const int col0 = (u.pn & 3) * BM + wc * 32 + 8 * fq;
        const float* gp = GATE + ((u.pm & 7) * NE + (u.pm >> 3)) * CAP + wr * 64 + fr;
#pragma unroll
        for (int ai = 0; ai < 2; ++ai)
#pragma unroll
            for (int m = 0; m < 4; ++m) { const float gt = gp[ai * HALF + m * 16] * (Y8_SCALE / (A8_SCALE * W8_SCALE));
                unsigned char* rowp = Y + (size_t)(u.pm * BM + ai * HALF + wr * 64 + m * 16 + fr) * DM + col0;
#pragma unroll
                for (int bj = 0; bj < 2; ++bj) { const f32x4 v0 = acc[ai][bj][m][0] * gt, v1 = acc[ai][bj][m][1] * gt;
                    u32x2 w; w.x = cvt4_fp8(v0[0], v0[1], v0[2], v0[3]); w.y = cvt4_fp8(v1[0], v1[1], v1[2], v1[3]);
                    *(u32x2*)(rowp + bj * HALF) = w; } }
    }
};
}

#define LAS3 __attribute__((address_space(3)))
constexpr int RING_BYTES_C = 131072, LDS_TOP_C = 147456;
__device__ __forceinline__ void phase_inproj(const Args& a, LAS3 unsigned char* lds) {
    const int G = gridDim.x;
    const int wave = __builtin_amdgcn_readfirstlane(threadIdx.x >> 6), lane = threadIdx.x & 63;
    pg8::Gemm g{(const bf16_t*)(a.ws + WS_H), (const bf16_t*)(a.ws + WS_WIN), NTOK + NCTX, DIN, DM, nullptr};
    pg8::GroupedOrder S; S.init((NTOK / 256) * (DIN / 256), DIN / 256, 0, G, blockIdx.x, (NCTX / 256) * 4);
    pg8::EpiInproj E{(bf16_t*)(a.ws + WS_Z), (bf16_t*)(a.ws + WS_KVC)};
    pg8::gemm_phase<pg8::EpiInproj, pg8::GroupedOrder, true, true>(lds, g, S, E);
    const int nun = (NTOK / 256) * (DIN / 256) + (NCTX / 256) * 4, rounds = (nun + G - 1) / G, first_idle = nun - (rounds - 1) * G;
    const unsigned scr = (unsigned)(size_t)lds + wave * 4096;
    if (first_idle + 32 <= G) { if ((int)blockIdx.x >= first_idle) wconv_stream4(a, scr, WI_MIX_END + ((int)blockIdx.x - first_idle) * 8 + wave, WI_DENSE + WI_MOE, (G - first_idle) * 8, lane); }
    else wconv_range<false>(a, scr, WI_MIX_END + (int)blockIdx.x * 8 + wave, WI_DENSE + WI_MOE, G * 8, lane);
}
__device__ __forceinline__ void phase_outproj(const Args& a, LAS3 unsigned char* lds) {
    pg8::Gemm g{(const bf16_t*)(a.ws + WS_OPRE), (const bf16_t*)(a.ws + WS_WOUT), NTOK, DM, DM, nullptr};
    pg8::GroupedOrder S; S.init((NTOK / 256) * (DM / 256), DM / 256, 0, gridDim.x, blockIdx.x, 0);
    pg8::EpiOutproj E{a.in[0], (bf16_t*)(a.ws + WS_XNB), (const float*)(a.ws + WS_MOD), (const float*)(a.ws + WS_SS), (LAS3 float*)(lds + 131072 + 1024)};
    pg8::gemm_phase<pg8::EpiOutproj, pg8::GroupedOrder, true, true>(lds, g, S, E);
}
__device__ __forceinline__ void phase_moe1(const Args& a, LAS3 unsigned char* lds) {
    pg8::Gemm g{(const bf16_t*)(a.ws + WS_H2), (const bf16_t*)(a.ws + WS_W1), NE * 2048, NE * 3072, DM / 2, (const int*)(a.ws + WS_IDX)};
    pg8::GroupedOrder S; S.init(NE * 8 * 12, 12, 1, gridDim.x, blockIdx.x, 0);
    pg8::EpiMoe1 E{a.ws + WS_ACT};
    pg8::gemm_phase<pg8::EpiMoe1, pg8::GroupedOrder, true, true, true, true>(lds, g, S, E);
}
__device__ __forceinline__ void phase_moe2(const Args& a, LAS3 unsigned char* lds) {
    pg8::Gemm g{(const bf16_t*)(a.ws + WS_ACT), (const bf16_t*)(a.ws + WS_W2), NE * 2048, NE * DM, DE / 2, nullptr};
    pg8::GroupedOrder S; S.init(NE * 8 * 4, 4, 1, gridDim.x, blockIdx.x, 0);
    pg8::EpiMoe2 E{a.ws + WS_Y, (const float*)(a.ws + WS_GATE)};
    pg8::gemm_phase<pg8::EpiMoe2, pg8::GroupedOrder, true, true, false, true>(lds, g, S, E);
}
namespace mix {
#define MLAS __attribute__((address_space(3)))
typedef short v4i16_t __attribute__((ext_vector_type(4)));
__device__ __forceinline__ void vtr2(v4i16_t& lo, v4i16_t& hi, unsigned addr) {
    asm volatile("ds_read_b64_tr_b16 %0, %2\n\tds_read_b64_tr_b16 %1, %2 offset:2048" : "=&v"(lo), "=&v"(hi) : "v"(addr) : "memory");
}
#define VTR_WAIT(N) do { asm volatile("s_waitcnt lgkmcnt(" #N ")" ::: "memory"); __builtin_amdgcn_sched_barrier(0); } while (0)
__device__ __forceinline__ unsigned lds_addr(const MLAS unsigned char* p) { return (unsigned)(size_t)p; }
__device__ __forceinline__ float max_g4(float v) {
    const auto r1 = __builtin_amdgcn_permlane16_swap(__float_as_uint(v), __float_as_uint(v), false, false); v = fmaxf(__uint_as_float(r1[0]), __uint_as_float(r1[1]));
    const auto r2 = __builtin_amdgcn_permlane32_swap(__float_as_uint(v), __float_as_uint(v), false, false); return fmaxf(__uint_as_float(r2[0]), __uint_as_float(r2[1]));
}
__device__ __forceinline__ float sum_g4(float v) {
    const auto r1 = __builtin_amdgcn_permlane16_swap(__float_as_uint(v), __float_as_uint(v), false, false); v = __uint_as_float(r1[0]) + __uint_as_float(r1[1]);
    const auto r2 = __builtin_amdgcn_permlane32_swap(__float_as_uint(v), __float_as_uint(v), false, false); return __uint_as_float(r2[0]) + __uint_as_float(r2[1]);
}
__device__ __forceinline__ int clampi(int v, int lo, int hi) { return v < lo ? lo : (v > hi ? hi : v); }
constexpr int NSLOT = 6, SLOTB = 16384;
constexpr int BIASB = 15 * 128 * 4;
constexpr int L_RING = 0, L_BIAS = NSLOT * SLOTB, L_STAT = L_BIAS + BIASB, L_WSCR = L_STAT + 2048, WSCRB = 4352, L_ZN = 0;
static_assert(L_WSCR + 8 * WSCRB <= 147456 - 512, "mixer LDS map");
constexpr float NEG = -1e30f;
#ifndef ATT_HOST_MAX_V
#define ATT_HOST_MAX_V 18
#endif
constexpr int ATT_HOST_MAX = ATT_HOST_MAX_V;
#define ATT_WAIT_BAR(N) asm volatile("s_waitcnt vmcnt(" #N ") lgkmcnt(0)\n\ts_barrier" ::: "memory")

struct AttnStream {
    int u0, nu, iu, it, us;
    int nrows; const bf16_t* rp;
};
__device__ __forceinline__ void unit_geom(int unit, int& b, int& h, int& r0, int& U0, int& nrows) {
    b = unit >> 7; h = (unit >> 4) & 7; r0 = (unit & 15) * 2; U0 = clampi(r0 - 4, 0, ROWS - 8); const int nwin = clampi(r0 - 3, 0, ROWS - 8) + 8 - U0; nrows = (nwin + 1) & ~1;
}
__device__ __forceinline__ void attn_seek(const Args& a, AttnStream& S, int wid, int lane) {
    const bf16_t* Z = (const bf16_t*)(a.ws + WS_Z); const bf16_t* KVC = (const bf16_t*)(a.ws + WS_KVC);
    int b, h, r0, U0, nrows; unit_geom(S.u0 + S.iu * S.us, b, h, r0, U0, nrows); S.nrows = nrows;
    const int row = 8 * wid + (lane >> 3);
    S.rp = (S.it < nrows) ? Z + (size_t)(b * SEQ + (U0 + S.it) * GW + row) * DIN + DNA + h * HD
                          : KVC + (size_t)(b * CTXL + (S.it - nrows) * 64 + row) * DM + h * HD;
}
__device__ __forceinline__ void attn_issue(const Args& a, MLAS unsigned char* lds, AttnStream& S, int slot, int wid, int lane) {
    const int ck = (lane & 7) ^ (lane >> 3);
    const int cv = ((((lane & 7) >> 1) ^ ((lane >> 4) & 3)) << 1) | (lane & 1);
    MLAS unsigned char* dst = lds + L_RING + slot * SLOTB + wid * 1024;
    __builtin_amdgcn_global_load_lds((const unsigned*)(S.rp + ck * 8), (MLAS unsigned*)dst, 16, 0, 0);
    __builtin_amdgcn_global_load_lds((const unsigned*)(S.rp + 512 + cv * 8), (MLAS unsigned*)(dst + 8192), 16, 0, 0);
    const int it1 = S.it + 1;
    if (it1 < S.nrows) { S.it = it1; S.rp += (size_t)GW * DIN; }
    else if (it1 > S.nrows && it1 < S.nrows + CTXL / 64) { S.it = it1; S.rp += (size_t)64 * DM; }
    else if (it1 == S.nrows) { S.it = it1; attn_seek(a, S, wid, lane); }
    else if (S.iu + 1 < S.nu) { ++S.iu; S.it = 0; attn_seek(a, S, wid, lane); }
}

template <bool WIN>
__device__ __forceinline__ void attn_step(const MLAS unsigned char* Kp0, const MLAS unsigned char* Kp1, bool use0, bool use1, const MLAS float* brow0, const MLAS float* brow1,
                                          const f32x4 (&negmask)[2], const bf16x8 qf0, const bf16x8 qf1, float& mrun, float& lrun, f32x4 (&O)[4], int koff0, int koff1, int voff, int vsw) {
    const unsigned va0 = lds_addr(Kp0 + 8192) + voff, va1 = lds_addr(Kp1 + 8192) + voff;
    v4i16_t x0[4], y0[4], x1[4], y1[4];
    if (use0) {
#pragma unroll
        for (int db = 0; db < 4; ++db) vtr2(x0[db], y0[db], va0 + ((db ^ vsw) << 5)); }
    if (use1) {
#pragma unroll
        for (int db = 0; db < 4; ++db) vtr2(x1[db], y1[db], va1 + ((db ^ vsw) << 5)); }
    f32x4 s[4];
#pragma unroll
    for (int pr = 0; pr < 2; ++pr) {
        const bool use = pr ? use1 : use0; const MLAS unsigned char* Kp = pr ? Kp1 : Kp0;
        if (use) {
#pragma unroll
            for (int kbi = 0; kbi < 2; ++kbi) {
                const bf16x8 a0 = *(const MLAS bf16x8*)(Kp + kbi * 2048 + koff0), a1 = *(const MLAS bf16x8*)(Kp + kbi * 2048 + koff1);
                const f32x4 c0 = WIN ? negmask[kbi] : (f32x4){0.f, 0.f, 0.f, 0.f};
                const f32x4 acc = __builtin_amdgcn_mfma_f32_16x16x32_bf16(a0, qf0, c0, 0, 0, 0);
                s[2 * pr + kbi] = __builtin_amdgcn_mfma_f32_16x16x32_bf16(a1, qf1, acc, 0, 0, 0);
            }
        } else { s[2 * pr] = (f32x4){NEG, NEG, NEG, NEG}; s[2 * pr + 1] = (f32x4){NEG, NEG, NEG, NEG}; }
    }
    if (WIN) {
        f32x4 bv[4];
#pragma unroll
        for (int pr = 0; pr < 2; ++pr) { const MLAS float* br = pr ? brow1 : brow0;
#pragma unroll
            for (int kbi = 0; kbi < 2; ++kbi)
#pragma unroll
                for (int j = 0; j < 4; ++j) bv[2 * pr + kbi][j] = br[kbi * 16 + j]; }
        asm volatile("" : "+v"(bv[0]), "+v"(bv[1]), "+v"(bv[2]), "+v"(bv[3]));
#pragma unroll
        for (int k = 0; k < 4; ++k) s[k] = s[k] + bv[k];
    }
    float mt = fmaxf(fmaxf(s[0][0], s[0][1]), fmaxf(s[0][2], s[0][3]));
#pragma unroll
    for (int k = 1; k < 4; ++k) mt = fmaxf(fmaxf(mt, fmaxf(s[k][0], s[k][1])), fmaxf(s[k][2], s[k][3]));
    mt = max_g4(mt);
    if (__any(mt > mrun + 8.f)) {
        const float mn = fmaxf(mrun, mt), alpha = __builtin_amdgcn_exp2f(mrun - mn); mrun = mn; lrun *= alpha;
#pragma unroll
        for (int db = 0; db < 4; ++db) O[db] = O[db] * alpha;
    }
#pragma unroll
    for (int k = 0; k < 4; ++k)
#pragma unroll
        for (int j = 0; j < 4; ++j) s[k][j] = __builtin_amdgcn_exp2f(s[k][j] - mrun);
    { const f32x4 t4 = (s[0] + s[1]) + (s[2] + s[3]); lrun += (t4[0] + t4[1]) + (t4[2] + t4[3]); }
    {
        u32x4 pw0, pw1;
        pw0.x = cvtpk(s[0][0], s[0][1]); pw0.y = cvtpk(s[0][2], s[0][3]); pw0.z = cvtpk(s[1][0], s[1][1]); pw0.w = cvtpk(s[1][2], s[1][3]);
        pw1.x = cvtpk(s[2][0], s[2][1]); pw1.y = cvtpk(s[2][2], s[2][3]); pw1.z = cvtpk(s[3][0], s[3][1]); pw1.w = cvtpk(s[3][2], s[3][3]);
        const bf16x8 pf0 = __builtin_bit_cast(bf16x8, pw0), pf1 = __builtin_bit_cast(bf16x8, pw1);
        if (use0) {
            VTR_WAIT(0);
#pragma unroll
            for (int db = 0; db < 4; ++db) { const bf16x8 af = (bf16x8){x0[db][0], x0[db][1], x0[db][2], x0[db][3], y0[db][0], y0[db][1], y0[db][2], y0[db][3]};
                O[db] = __builtin_amdgcn_mfma_f32_16x16x32_bf16(af, pf0, O[db], 0, 0, 0); }
        }
        if (use1) {
            VTR_WAIT(0);
#pragma unroll
            for (int db = 0; db < 4; ++db) { const bf16x8 af = (bf16x8){x1[db][0], x1[db][1], x1[db][2], x1[db][3], y1[db][0], y1[db][1], y1[db][2], y1[db][3]};
                O[db] = __builtin_amdgcn_mfma_f32_16x16x32_bf16(af, pf1, O[db], 0, 0, 0); }
        }
    }
}

__device__ __forceinline__ void attn_units(const Args& a, MLAS unsigned char* lds, int u0, int nu, int us, int& wit, bool accum) {
    const int tid = threadIdx.x, lane = tid & 63, wid = __builtin_amdgcn_readfirstlane(tid >> 6);
    const int q = lane & 15, g = lane >> 4;
    const bf16_t* Z = (const bf16_t*)(a.ws + WS_Z); bf16_t* OP = (bf16_t*)(a.ws + WS_OPRE);
    AttnStream S; S.u0 = u0; S.nu = nu; S.iu = 0; S.it = 0; S.us = us; attn_seek(a, S, wid, lane);
    int islot = 0, cslot = 0;
#pragma unroll
    for (int d = 0; d < NSLOT; ++d) { attn_issue(a, lds, S, islot, wid, lane); islot = (islot + 1 == NSLOT) ? 0 : islot + 1; }
    MLAS float* biasl = (MLAS float*)(lds + L_BIAS);
    const int koff0 = q * 128 + ((g ^ (q & 7)) << 4), koff1 = q * 128 + (((4 + g) ^ (q & 7)) << 4);
    const int q4 = q >> 2, p4 = q & 3, vrow = 4 * g + q4;
    const int vsw = (vrow >> 1) & 3, voff = vrow * 128 + (p4 & 1) * 8 + ((p4 >> 1) << 4);
    const int qg = wid & 3, qc = 16 * qg + q, cs = clampi(qc - 8, 0, GW - 16);
    const int kcs = (qg == 0) ? 0 : ((qg == 1) ? 8 : ((qg == 2) ? 24 : 32));
    f32x4 negmask[2];
#pragma unroll
    for (int kbi = 0; kbi < 2; ++kbi)
#pragma unroll
        for (int j = 0; j < 4; ++j) { const int kc = kcs + 16 * kbi + 4 * g + j; negmask[kbi][j] = (kc >= cs && kc < cs + 16) ? 0.f : NEG; }
    const int bidx0 = kcs + 4 * g - qc + 63;
    int hprev = -1, prev_n = 0;
    f32x4 wr_[8]; unsigned char* wop_ = nullptr; bool wfly = false; int wage = 0, whosted = 0, wstep = 0;
    const unsigned wscr = lds_addr(lds + L_WSCR + wid * WSCRB);
    const int wstride = (int)gridDim.x * 8, wlast = WI_MIX_END;
    int b, h, r0, U0, nrows; unit_geom(u0, b, h, r0, U0, nrows);
    bf16x8 qn0, qn1;
    { const bf16_t* qp = Z + (size_t)(b * SEQ + (r0 + (wid >> 2)) * GW + qc) * DIN + h * HD + 8 * g; qn0 = *(const bf16x8*)qp; qn1 = *(const bf16x8*)(qp + 32); }
    for (int iu = 0; iu < nu; ++iu) {
        unit_geom(u0 + iu * us, b, h, r0, U0, nrows);
        const int qrow = r0 + (wid >> 2), rsq = clampi(qrow - 4, 0, ROWS - 8);
        if (h != hprev) {
            if (hprev >= 0) ATT_WAIT_BAR(0);
            for (int i = tid; i < 15 * 128; i += 512) { const int rr = i >> 7, d = (i & 127) - 48; biasl[i] = (d >= 0 && d < 31) ? LOG2E * a.in[8][(h * 15 + rr) * 31 + d] : 0.f; }
            hprev = h;
        }
        const bf16x8 qf0 = qn0, qf1 = qn1;
        if (iu + 1 < nu) { int b2, h2, r2, U2, n2; unit_geom(u0 + (iu + 1) * us, b2, h2, r2, U2, n2);
            const bf16_t* qp = Z + (size_t)(b2 * SEQ + (r2 + (wid >> 2)) * GW + qc) * DIN + h2 * HD + 8 * g; qn0 = *(const bf16x8*)qp; qn1 = *(const bf16x8*)(qp + 32); }
        float mrun = NEG, lrun = 0.f;
        f32x4 O[4];
#pragma unroll
        for (int db = 0; db < 4; ++db) O[db] = (f32x4){0.f, 0.f, 0.f, 0.f};
        const int nsw = nrows >> 1, nst = nsw + CTXL / 64;
        for (int st = 0; st < nst; ++st) {
            if (wfly) { ATT_WAIT_BAR(12); ++wage; } else { ATT_WAIT_BAR(4); }
            if (wfly && wage == 2) { titem8_store(wop_, wr_, wscr, lane); wfly = false; }
            for (int k = 0; k < prev_n; ++k) { attn_issue(a, lds, S, islot, wid, lane); islot = (islot + 1 == NSLOT) ? 0 : islot + 1; }
            ++wstep;
            if (!wfly && wit < wlast && whosted < ATT_HOST_MAX && (wstep > 1 || (wid & 4) == 0)) { const TItem I = wconv_item(a, wit); titem8_load(I, wr_, lane); wop_ = titem8_outptr(I, lane); wit += wstride; wfly = true; wage = 0; ++whosted; }
            const MLAS unsigned char* sl0 = lds + L_RING + cslot * SLOTB;
            if (st < nsw) {
                const int c1 = (cslot + 1 == NSLOT) ? 0 : cslot + 1; const MLAS unsigned char* sl1 = lds + L_RING + c1 * SLOTB;
                const int krA = U0 + 2 * st, krB = krA + 1;
                const bool uA = (krA >= rsq) && (krA < rsq + 8), uB = (krB >= rsq) && (krB < rsq + 8);
                if (uA || uB)
                    attn_step<true>(sl0 + kcs * 128, sl1 + kcs * 128, uA, uB, biasl + clampi(krA - qrow + 7, 0, 14) * 128 + bidx0, biasl + clampi(krB - qrow + 7, 0, 14) * 128 + bidx0, negmask, qf0, qf1, mrun, lrun, O, koff0, koff1, voff, vsw);
                cslot = (c1 + 1 == NSLOT) ? 0 : c1 + 1; prev_n = 2;
            } else {
                attn_step<false>(sl0, sl0 + 32 * 128, true, true, biasl, biasl, negmask, qf0, qf1, mrun, lrun, O, koff0, koff1, voff, vsw);
                cslot = (cslot + 1 == NSLOT) ? 0 : cslot + 1; prev_n = 1;
            }
        }
        const float l = sum_g4(lrun);
        const float inv = 1.f / l;
        bf16_t* op = OP + (size_t)(b * SEQ + qrow * GW + qc) * DM + h * HD + 4 * g;
        float ssq = 0.f;
#pragma unroll
        for (int db = 0; db < 4; ++db) { const f32x4 o = O[db] * inv; u32x2 w; w.x = cvtpk(o[0], o[1]); w.y = cvtpk(o[2], o[3]); *(u32x2*)(op + db * 16) = w; ssq += (o[0] * o[0] + o[1] * o[1]) + (o[2] * o[2] + o[3] * o[3]); }
        ssq = sum_g4(ssq);
        if (g == 0 && accum) atomicAdd((float*)(a.ws + WS_SS) + (size_t)(b * SEQ + qrow * GW + qc) * 2, ssq);
    }
    if (wfly) titem8_store(wop_, wr_, wscr, lane);
    ATT_WAIT_BAR(0);
}

__device__ __forceinline__ void gmlp_unit(const Args& a, MLAS unsigned char* lds, int unit, bool accum, int& wit) {
    const int tid = threadIdx.x, lane = tid & 63, wid = __builtin_amdgcn_readfirstlane(tid >> 6);
    const int q = lane & 15, g = lane >> 4;
    const bf16_t* Z = (const bf16_t*)(a.ws + WS_Z); bf16_t* OP = (bf16_t*)(a.ws + WS_OPRE);
    const int half = unit & 1, c = (unit >> 1) & 15, b = unit >> 5;
    const int row0 = b * SEQ + c * 128;
    MLAS float* st = (MLAS float*)(lds + L_STAT);
    const int srow = tid >> 3, sch = tid & 7;
    const int prow = row0 + wid * 16 + q;
    u32x4 zs[16], zt[4][2];
#pragma unroll
    for (int rr = 0; rr < 16; ++rr) zs[rr] = *((const u32x4*)(Z + (size_t)(row0 + wid * 16 + rr) * DIN + 2048) + lane);
    bf16x8 bfr[4][4]; f32x4 gn[4][2]; u32x2 uw[4][4]; float bsv[4];
#define GMLP_LOAD_EARLY(gi_) do { const int ch0_ = (half * 4 + (gi_)) * 64; \
        gn[gi_][0] = *(const f32x4*)(a.in[11] + ch0_ + sch * 8); gn[gi_][1] = *(const f32x4*)(a.in[11] + ch0_ + sch * 8 + 4); \
        _Pragma("unroll") for (int hh = 0; hh < 2; ++hh) zt[gi_][hh] = *(const u32x4*)(Z + (size_t)(row0 + srow + 64 * hh) * DIN + 2048 + ch0_ + sch * 8); } while (0)
#define GMLP_LOAD_LATE(gi_) do { const int g8_ = half * 4 + (gi_), ch0_ = g8_ * 64; \
        const float* wrow_ = a.in[9] + (size_t)(g8_ * 128 + wid * 16 + q) * 128 + 4 * g; \
        _Pragma("unroll") for (int ks = 0; ks < 4; ++ks) { const f32x4 w0 = *(const f32x4*)(wrow_ + ks * 32), w1 = *(const f32x4*)(wrow_ + ks * 32 + 16); \
            u32x4 pw; pw.x = cvtpk(w0[0], w0[1]); pw.y = cvtpk(w0[2], w0[3]); pw.z = cvtpk(w1[0], w1[1]); pw.w = cvtpk(w1[2], w1[3]); bfr[gi_][ks] = __builtin_bit_cast(bf16x8, pw); } \
        _Pragma("unroll") for (int db = 0; db < 4; ++db) uw[gi_][db] = *(const u32x2*)(Z + (size_t)prow * DIN + 1536 + ch0_ + db * 16 + 4 * g); \
        bsv[gi_] = a.in[10][g8_ * 128 + wid * 16 + q]; } while (0)
    GMLP_LOAD_EARLY(0);
#pragma unroll
    for (int rr = 0; rr < 16; ++rr) {
        const u32x4 w = zs[rr];
        const float v[8] = {bflo(w.x), bfhi(w.x), bflo(w.y), bfhi(w.y), bflo(w.z), bfhi(w.z), bflo(w.w), bfhi(w.w)};
        float s = 0.f, s2 = 0.f;
#pragma unroll
        for (int i = 0; i < 8; ++i) { s += v[i]; s2 += v[i] * v[i]; }
        s = wave_sum(s); s2 = wave_sum(s2);
        const float mean = s * (1.f / DSG), var = fmaxf(s2 * (1.f / DSG) - mean * mean, 0.f);
        if (lane == 0) { st[(wid * 16 + rr) * 2] = mean; st[(wid * 16 + rr) * 2 + 1] = rsqrtf(var + EPS); }
    }
    LDS_BARRIER();
    const int q4 = q >> 2, p4 = q & 3;
    const int vrow = 4 * g + q4, vsw = (vrow >> 1) & 3, voff = vrow * 128 + (p4 & 1) * 8 + ((p4 >> 1) << 4);
    float ssq = 0.f;
#pragma unroll
    for (int gi = 0; gi < 4; ++gi) {
        const int g8 = half * 4 + gi, ch0 = g8 * 64;
        MLAS unsigned char* zb = lds + L_ZN + (gi & 1) * 16384;
        f32x4 wr_[8]; const int wmine = wit; const bool whave = accum && (wit < WI_MIX_END);
        unsigned char* wop_ = nullptr;
        if (whave) { const TItem I = wconv_item(a, wmine); titem8_load(I, wr_, lane); wop_ = titem8_outptr(I, lane); wit += (int)gridDim.x * 8; }
        GMLP_LOAD_LATE(gi);
        if (gi + 1 < 4) GMLP_LOAD_EARLY(gi + 1);
#pragma unroll
        for (int hh = 0; hh < 2; ++hh) {
            const int r = srow + 64 * hh;
            const u32x4 w = zt[gi][hh];
            const float mean = st[r * 2], rstd = st[r * 2 + 1];
            const f32x4 gn0 = gn[gi][0] * rstd, gn1 = gn[gi][1] * rstd;
            u32x4 o;
            o.x = cvtpk((bflo(w.x) - mean) * gn0[0], (bfhi(w.x) - mean) * gn0[1]); o.y = cvtpk((bflo(w.y) - mean) * gn0[2], (bfhi(w.y) - mean) * gn0[3]);
            o.z = cvtpk((bflo(w.z) - mean) * gn1[0], (bfhi(w.z) - mean) * gn1[1]); o.w = cvtpk((bflo(w.w) - mean) * gn1[2], (bfhi(w.w) - mean) * gn1[3]);
            *(MLAS u32x4*)(zb + r * 128 + (((((sch >> 1) ^ ((r >> 1) & 3)) << 1) | (sch & 1)) << 4)) = o;
        }
        LDS_BARRIER();
        f32x4 D[4];
#pragma unroll
        for (int db = 0; db < 4; ++db) D[db] = (f32x4){0.f, 0.f, 0.f, 0.f};
        const unsigned zba = lds_addr(zb) + voff;
#pragma unroll
        for (int kh = 0; kh < 2; ++kh) {
            v4i16_t x0[2][4], y0[2][4];
#pragma unroll
            for (int k2 = 0; k2 < 2; ++k2)
#pragma unroll
                for (int db = 0; db < 4; ++db) vtr2(x0[k2][db], y0[k2][db], zba + (2 * kh + k2) * 4096 + ((db ^ vsw) << 5));
#pragma unroll
            for (int k2 = 0; k2 < 2; ++k2) {
                if (k2 == 0) VTR_WAIT(8); else VTR_WAIT(0);
#pragma unroll
                for (int db = 0; db < 4; ++db) { const bf16x8 af = (bf16x8){x0[k2][db][0], x0[k2][db][1], x0[k2][db][2], x0[k2][db][3], y0[k2][db][0], y0[k2][db][1], y0[k2][db][2], y0[k2][db][3]};
                    D[db] = __builtin_amdgcn_mfma_f32_16x16x32_bf16(af, bfr[gi][2 * kh + k2], D[db], 0, 0, 0); }
            }
        }
#pragma unroll
        for (int db = 0; db < 4; ++db) {
            const float o0 = bflo(uw[gi][db].x) * (D[db][0] + bsv[gi]), o1 = bfhi(uw[gi][db].x) * (D[db][1] + bsv[gi]), o2 = bflo(uw[gi][db].y) * (D[db][2] + bsv[gi]), o3 = bfhi(uw[gi][db].y) * (D[db][3] + bsv[gi]);
            u32x2 w; w.x = cvtpk(o0, o1); w.y = cvtpk(o2, o3); ssq += (o0 * o0 + o1 * o1) + (o2 * o2 + o3 * o3);
            *(u32x2*)(OP + (size_t)prow * DM + DNA + ch0 + db * 16 + 4 * g) = w;
        }
        if (whave) titem8_store(wop_, wr_, lds_addr(lds + L_WSCR + wid * WSCRB), lane);
    }
    ssq = rows4_sum(ssq);
    if (g == 0 && accum) atomicAdd((float*)(a.ws + WS_SS) + (size_t)prow * 2 + 1, ssq);
    LDS_BARRIER();
#undef GMLP_LOAD_EARLY
#undef GMLP_LOAD_LATE
}

__device__ __forceinline__ void phase_mix(const Args& a, MLAS unsigned char* lds) {
    const int G = gridDim.x; const int vcu = (G % 8 == 0) ? ((int)blockIdx.x % 8) * (G / 8) + (int)blockIdx.x / 8 : (int)blockIdx.x;
    constexpr int NAU = NB * NH * (ROWS / 2), NGU = NB * (SEQ / 128) * 2;
    const int upc = (NAU + G - 1) / G;
    const int wave = __builtin_amdgcn_readfirstlane(threadIdx.x >> 6), lane = threadIdx.x & 63;
    int wit = WI_DENSE + (int)blockIdx.x * 8 + wave;
    if (upc == 4 && NAU == 4 * G) {
        const int u0 = (vcu >> 2) * 16 + (vcu & 3); attn_units(a, lds, u0, 4, 4, wit, true); if (REP_MASK_V & 0x10000u) attn_units(a, lds, u0, 4, 4, wit, false);
    } else { const int u0 = vcu * upc, nu = (u0 + upc <= NAU) ? upc : (NAU - u0); if (nu > 0) { attn_units(a, lds, u0, nu, 1, wit, true); if (REP_MASK_V & 0x10000u) attn_units(a, lds, u0, nu, 1, wit, false); } }
    for (int unit = vcu; unit < NGU; unit += G) { gmlp_unit(a, lds, unit, true, wit); if (REP_MASK_V & 0x20000u) gmlp_unit(a, lds, unit, false, wit); }
    wconv_range<false>(a, lds_addr(lds + L_WSCR + wave * WSCRB), wit, WI_MIX_END, G * 8, lane);
}
}
#define GAS __attribute__((address_space(1)))
#define LAS __attribute__((address_space(3)))
constexpr int NWAVES = 8;
constexpr int RING_BYTES = 131072;
constexpr int LDSCTL_OFF = 147456 - 512, MISC_OFF = LDSCTL_OFF + 320;
constexpr int LDS_BYTES = 147456;
constexpr size_t CTL_ZERO_BYTES = 384 * 1024;
constexpr int CW_BAR = 4096;

#define XB_TMO      128
#define XB_XCNT(j)  (256  + 64 * (j))
#define XB_XSUB(j)  (1280 + 64 * (j))
#define XB_XGEN(j)  (2304 + 64 * (j))
#define XB_TOP      3328
#define XB_TOPGEN   3392
#define XCD_BAR_WORDS 3456
#define XB_SPIN_CAP (1u << 18)

__device__ __forceinline__ unsigned xb_ld(unsigned* p)              { return __hip_atomic_load(p, __ATOMIC_RELAXED, __HIP_MEMORY_SCOPE_AGENT); }
__device__ __forceinline__ unsigned xb_add(unsigned* p, unsigned v) { return __hip_atomic_fetch_add(p, v, __ATOMIC_RELAXED, __HIP_MEMORY_SCOPE_AGENT); }
__device__ __forceinline__ unsigned xb_xcc_id() { return (unsigned)__builtin_amdgcn_s_getreg((3 << 11) | 20) & 0xFu; }
#define XB_SPIN(cond, bar) do { unsigned _sp = 0; while (cond) { __builtin_amdgcn_s_sleep(1); \
    if ((++_sp & 255u) == 0u) { if (xb_ld(&(bar)[XB_TMO])) break; if (_sp > XB_SPIN_CAP) { atomicAdd(&(bar)[XB_TMO], 1u); break; } } } } while (0)

struct XcdBarrier { unsigned* bar; unsigned x; volatile LAS unsigned* st; };

__device__ __forceinline__ XcdBarrier xcd_barrier_post(unsigned* bar, volatile LAS unsigned* st) {
    XcdBarrier b; b.bar = bar; b.x = xb_xcc_id(); b.st = st;
    if (threadIdx.x == 0) (void)xb_add(&bar[XB_XCNT(b.x)], 1u);
    return b;
}
__device__ __forceinline__ void xcd_barrier_complete(unsigned* bar, unsigned x, unsigned& nloc, unsigned& nx) {
    const unsigned G = gridDim.x * gridDim.y * gridDim.z;
    unsigned sum, cnt, mine, sp = 0u;
    for (;;) {
        sum = 0u; cnt = 0u; mine = 0u;
#pragma unroll
        for (unsigned j = 0; j < 16; ++j) { const unsigned c = xb_ld(&bar[XB_XCNT(j)]); sum += c; cnt += (c > 0u) ? 1u : 0u; mine = (j == x) ? c : mine; }
        if (sum == G) break;
        __builtin_amdgcn_s_sleep(1);
        if ((++sp & 255u) == 0u) { if (xb_ld(&bar[XB_TMO])) break; if (sp > XB_SPIN_CAP) { atomicAdd(&bar[XB_TMO], 1u); break; } }
    }
    nloc = mine > 0u ? mine : 1u; nx = cnt > 0u ? cnt : 1u;
}
__device__ __forceinline__ void xcd_barrier(const XcdBarrier& b) {
    asm volatile("s_waitcnt vmcnt(0)" ::: "memory");
    __syncthreads();
    if (threadIdx.x == 0) {
        unsigned* bar = b.bar;
        __builtin_amdgcn_s_waitcnt(0);
        unsigned nloc = b.st[0], nx = b.st[1];
        if (nloc == 0u) { xcd_barrier_complete(bar, b.x, nloc, nx); b.st[0] = nloc; b.st[1] = nx; }
        const unsigned old = xb_add(&bar[XB_XSUB(b.x)], 1u);
        const unsigned gen = old / nloc;
        if (old + 1u == (gen + 1u) * nloc) {
            __builtin_amdgcn_fence(__ATOMIC_RELEASE, "agent");
            asm volatile("s_waitcnt vmcnt(0)" ::: "memory");
            (void)xb_add(&bar[XB_TOP], 1u);
        }
        XB_SPIN(xb_ld(&bar[XB_TOP]) < (gen + 1u) * nx, bar);
        __builtin_amdgcn_fence(__ATOMIC_ACQUIRE, "agent");
        asm volatile("s_waitcnt vmcnt(0)" ::: "memory");
    }
    __syncthreads();
}

constexpr int NPHASE = 10;
constexpr unsigned REP_MASK = REP_MASK_V;
__global__ void __launch_bounds__(NWAVES * 64, 2) mk_fwd(Args a) {
    extern __shared__ __attribute__((aligned(16))) unsigned char lds_raw[];
    float* lds = (float*)lds_raw;
    LAS unsigned char* ldsl = (LAS unsigned char*)lds_raw;
    for (int u = threadIdx.x; u < 512 / 4; u += NWAVES * 64) ((LAS unsigned*)(ldsl + LDSCTL_OFF))[u] = 0u;
    __syncthreads();
    unsigned* ctl = (unsigned*)(a.ws + WS_CTL);
    XcdBarrier bar = xcd_barrier_post(ctl + CW_BAR, (volatile LAS unsigned*)(ldsl + MISC_OFF) + 8);
    const int lo = a.ph_lo, hi = a.ph_hi;
#define IN(k) (lo <= (k) && (k) < hi)
#define SEAM(k) do { if (IN(k) && IN((k) + 1)) xcd_barrier(bar); } while (0)
#define REP(k, body) do { if (IN(k)) { body; if ((REP_MASK >> (k)) & 1u) { xcd_barrier(bar); body; } } } while (0)
    REP(0, { phase_mod(a, lds); phase_wconv(a, lds); }); if (IN(0) && IN(1)) mod_pre_wait(a);
    REP(1, { phase_prenorm(a); }); SEAM(1);
    REP(2, { phase_inproj(a, ldsl); }); SEAM(2);
    REP(3, { mix::phase_mix(a, ldsl); }); SEAM(3);
    REP(4, { phase_outproj(a, ldsl); }); SEAM(4);
    if (gridDim.x == NTOK / 64) { if (IN(5)) phase_norm2_topk(a, lds); SEAM(5); }
    else { REP(5, { phase_norm2(a, lds); }); SEAM(5); REP(6, { phase_topk(a, lds); }); if (IN(6)) xcd_barrier(bar); }
    REP(7, { phase_moe1(a, ldsl); }); SEAM(7);
    REP(8, { phase_moe2(a, ldsl); }); SEAM(8);
    if (IN(9)) { if (REP_MASK & 0x200u) { phase_final(a, (float*)(a.ws + WS_ACT)); xcd_barrier(bar); } phase_final(a, a.out); }
#undef REP
#undef IN
#undef SEAM
}

extern "C" void kernel_launch(void* const* d_in, const int* in_sizes, int n_in, void* d_out, int out_size, void* d_ws, size_t ws_size, hipStream_t stream) {
    static int grid = 0;
    if (grid == 0) {
        if (n_in != 21 || out_size != NTOK * DM || ws_size < WS_END) { fprintf(stderr, "kernel_launch: unexpected shapes n_in %d out %d ws %zu\n", n_in, out_size, ws_size); grid = -1; return; }
        int dev = 0, cus = 0, per_cu = 0;
        if (hipGetDevice(&dev) != hipSuccess || hipDeviceGetAttribute(&cus, hipDeviceAttributeMultiprocessorCount, dev) != hipSuccess) { grid = -1; return; }
        if (hipFuncSetAttribute((const void*)mk_fwd, hipFuncAttributeMaxDynamicSharedMemorySize, LDS_BYTES) != hipSuccess) { fprintf(stderr, "kernel_launch: hipFuncSetAttribute failed\n"); grid = -1; return; }
        if (hipOccupancyMaxActiveBlocksPerMultiprocessor(&per_cu, (const void*)mk_fwd, NWAVES * 64, LDS_BYTES) != hipSuccess || per_cu < 1)
            fprintf(stderr, "kernel_launch: note: occupancy query reports %d workgroups per CU\n", per_cu);
        (void)hipGetLastError();
        grid = cus;
    }
    if (grid < 0) return;
    if (hipMemsetAsync((char*)d_ws + WS_CTL, 0, CTL_ZERO_BYTES, stream) != hipSuccess) return;
    Args a{};
    for (int i = 0; i < 21; ++i) a.in[i] = (const float*)d_in[i];
    a.out = (float*)d_out; a.ws = (unsigned char*)d_ws; a.ph_lo = 0; a.ph_hi = NPHASE;
    hipLaunchKernelGGL(mk_fwd, dim3(grid), dim3(NWAVES * 64), LDS_BYTES, stream, a);
}
```
